# Optimizing an MI355X kernel written in HIP

```python
import jax, jax.numpy as jnp
from jax import lax
import numpy as np

D_MODEL = 1024
BATCH = 16
SEQ = 4096
DEPTH = 4
DEC_BATCH = 8
DEC_SEQ = 32
PAST_LEN = 2048

CHUNK = 64
Q_BLOCK = 128
HEAD_DIM = 64
RW_HEADS = 4
RW_WIDTH = RW_HEADS * HEAD_DIM
FOX_HEADS = 8
FOX_WIDTH = FOX_HEADS * HEAD_DIM
HG_HEADS = 4
HG_WIDTH = HG_HEADS * HEAD_DIM
D_MIX = RW_WIDTH + FOX_WIDTH + HG_WIDTH
RW_W_LORA = 32
RW_A_LORA = 32
RW_G_LORA = 64
RW_COLS = 3 * RW_WIDTH + RW_W_LORA + RW_A_LORA + RW_G_LORA
FOX_COLS = 3 * FOX_WIDTH + FOX_HEADS
HG_COLS = 4 * HG_WIDTH
IN_COLS = RW_COLS + FOX_COLS + HG_COLS
D_FF = -(-8 * D_MODEL // (3 * 256)) * 256
EPS = 1e-6
RW_GN_EPS = 64e-5
FOX_SCALE = HEAD_DIM ** -0.5
RW_SPLITS = [RW_WIDTH, 2 * RW_WIDTH, 3 * RW_WIDTH, 3 * RW_WIDTH + RW_W_LORA, 3 * RW_WIDTH + RW_W_LORA + RW_A_LORA]
F32 = jnp.float32

kernel_name = "hybrid_stream_rwkv7_fox_hgrn2_step"


def rmsnorm(x, g):
    xf = x.astype(F32)
    return xf * lax.rsqrt(jnp.mean(xf * xf, axis=-1, keepdims=True) + EPS) * g.astype(F32)


def rwkv7_mix(p, prev, S0, mu, w0, w2, a0, a2, g2, k_k, k_a, r_k, ln_w, ln_b):
    B, T, _ = p.shape
    p = p.astype(F32)
    p_prev = jnp.concatenate([prev.astype(F32), p[:, :-1]], axis=1)
    xs = p + mu * (p_prev - p)
    r, k, v, wl, al, gl = jnp.split(xs, RW_SPLITS, axis=-1)
    w_raw = -jax.nn.softplus(-(w0 + jnp.tanh(wl) @ w2)) - 0.5
    w = jnp.exp(-jnp.exp(w_raw))
    a = jax.nn.sigmoid(a0 + al @ a2)
    g = jax.nn.sigmoid(gl) @ g2
    hd = lambda z: z.reshape(B, T, RW_HEADS, HEAD_DIM)
    kk = hd(k * k_k)
    kk = kk / jnp.maximum(jnp.sqrt(jnp.sum(kk * kk, axis=-1, keepdims=True)), 1e-12)
    k = hd(k * (1.0 + (a - 1.0) * k_a))
    r, v, a, w = hd(r), hd(v), hd(a), hd(w)

    def step(S, inp):
        r_t, k_t, v_t, kk_t, a_t, w_t = inp
        s_kk = jnp.einsum('bhvk,bhk->bhv', S, kk_t)
        S = (S * w_t[:, :, None, :] - s_kk[..., None] * (kk_t * a_t)[:, :, None, :]
             + v_t[..., None] * k_t[:, :, None, :])
        return S, jnp.einsum('bhvk,bhk->bhv', S, r_t)

    tm = lambda z: jnp.swapaxes(z, 0, 1)
    S_T, y = lax.scan(step, S0.astype(F32), (tm(r), tm(k), tm(v), tm(kk), tm(a), tm(w)))
    y = tm(y)
    mean = jnp.mean(y, axis=-1, keepdims=True)
    var = jnp.mean(jnp.square(y - mean), axis=-1, keepdims=True)
    y = ((y - mean) * lax.rsqrt(var + RW_GN_EPS)).reshape(B, T, RW_WIDTH) * ln_w + ln_b
    bonus = jnp.sum(r * k * r_k, axis=-1, keepdims=True) * v
    y = (y + bonus.reshape(B, T, RW_WIDTH)) * g
    return y, S_T


def fox_attend(q, c_q, q_pos, k, v, c_k, k_pos):
    s = jnp.einsum('bqhd,bkhd->bhqk', q, k) * FOX_SCALE
    bias = jnp.swapaxes(c_q, 1, 2)[..., :, None] - jnp.swapaxes(c_k, 1, 2)[..., None, :]
    s = jnp.where(k_pos[None, :] <= q_pos[:, None], s + bias, -jnp.inf)
    return jnp.einsum('bhqk,bkhd->bqhd', jax.nn.softmax(s, axis=-1), v)


def fox_mix(p, b_f, cache_k, cache_v, cache_logf):
    B, T, _ = p.shape
    p = p.astype(F32)
    q, k, v, f = jnp.split(p, [FOX_WIDTH, 2 * FOX_WIDTH, 3 * FOX_WIDTH], axis=-1)
    q = q.reshape(B, T, FOX_HEADS, HEAD_DIM)
    k = k.reshape(B, T, FOX_HEADS, HEAD_DIM)
    v = v.reshape(B, T, FOX_HEADS, HEAD_DIM)
    logf = jax.nn.log_sigmoid(f + b_f)
    if cache_k is None:
        c = jnp.cumsum(logf, axis=1)
        k_pos = jnp.arange(T)

        def block(i):
            start = i * Q_BLOCK
            qb = lax.dynamic_slice_in_dim(q, start, Q_BLOCK, axis=1)
            cb = lax.dynamic_slice_in_dim(c, start, Q_BLOCK, axis=1)
            return fox_attend(qb, cb, start + jnp.arange(Q_BLOCK), k, v, c, k_pos)

        o = lax.map(block, jnp.arange(T // Q_BLOCK))
        o = jnp.swapaxes(o, 0, 1).reshape(B, T, FOX_WIDTH)
    else:
        P = cache_k.shape[1]
        k_all = jnp.concatenate([cache_k.astype(F32), k], axis=1)
        v_all = jnp.concatenate([cache_v.astype(F32), v], axis=1)
        c_all = jnp.cumsum(jnp.concatenate([cache_logf.astype(F32), logf], axis=1), axis=1)
        o = fox_attend(q, c_all[:, P:], P + jnp.arange(T), k_all, v_all, c_all, jnp.arange(P + T))
        o = o.reshape(B, T, FOX_WIDTH)
    return o, k, v, logf


def hgrn2_mix(p, lb, S0, norm_g, chunk):
    B, T, _ = p.shape
    p = p.astype(F32)
    q, fx, i, g = jnp.split(p, 4, axis=-1)
    log_f = jnp.logaddexp(jnp.log(lb), jnp.log1p(-lb) + jax.nn.log_sigmoid(fx))
    k = (1.0 - lb) * jax.nn.sigmoid(-fx)
    n = T // chunk

    def to_chunks(z):
        return z.reshape(B, n, chunk, HG_HEADS, HEAD_DIM).transpose(1, 0, 3, 2, 4)

    causal = jnp.tril(jnp.ones((chunk, chunk), dtype=bool))[:, :, None]

    def step(S, inp):
        qc, kc, vc, lfc = inp
        b = jnp.cumsum(lfc, axis=2)
        o_inter = jnp.einsum('bhtk,bhkv->bhtv', qc * jnp.exp(b), S)
        diff = b[:, :, :, None, :] - b[:, :, None, :, :]
        dec = jnp.where(causal, jnp.exp(jnp.where(causal, diff, 0.0)), 0.0)
        attn = jnp.sum(qc[:, :, :, None, :] * kc[:, :, None, :, :] * dec, axis=-1)
        o = o_inter + jnp.einsum('bhts,bhsv->bhtv', attn, vc)
        b_last = b[:, :, -1:, :]
        S = (jnp.exp(b_last)[:, :, 0, :, None] * S
             + jnp.einsum('bhsk,bhsv->bhkv', kc * jnp.exp(b_last - b), vc))
        return S, o

    S_T, o = lax.scan(step, S0.astype(F32), (to_chunks(q), to_chunks(k), to_chunks(i), to_chunks(log_f)))
    o = o.transpose(1, 0, 3, 2, 4).reshape(B, T, HG_HEADS, HEAD_DIM)
    o = o * lax.rsqrt(jnp.mean(o * o, axis=-1, keepdims=True) + EPS)
    o = o.reshape(B, T, HG_WIDTH) * norm_g * jax.nn.silu(g)
    return o, S_T


def trunk_layer(x, c, p, rw_prev, rw_S, hg_S, fox_cache, hg_chunk):
    mod = jax.nn.silu(c.astype(F32)) @ p["w_ada"] + p["b_ada"]
    sh1, sc1, ga1, sh2, sc2, ga2 = [m[:, None, :] for m in jnp.split(mod, 6, axis=-1)]
    h = rmsnorm(x, p["norm1_g"]) * (1.0 + sc1) + sh1
    proj = h @ p["w_in"]
    p_rw, p_fox, p_hg = jnp.split(proj, [RW_COLS, RW_COLS + FOX_COLS], axis=-1)
    y_rw, rw_S_new = rwkv7_mix(p_rw, rw_prev, rw_S, *p["rw"])
    y_fox, k_new, v_new, logf_new = fox_mix(p_fox, p["fox_b_f"], *fox_cache)
    y_hg, hg_S_new = hgrn2_mix(p_hg, p["hg_lb"], hg_S, p["hg_norm_g"], hg_chunk)
    mix = jnp.concatenate([y_rw, y_fox, y_hg], axis=-1) @ p["w_out"]
    x = x + (ga1 * mix).astype(x.dtype)
    h2 = rmsnorm(x, p["norm2_g"]) * (1.0 + sc2) + sh2
    gate, up = jnp.split(h2 @ p["w_ffn_in"], 2, axis=-1)
    x = x + (ga2 * ((jax.nn.silu(gate) * up) @ p["w_ffn_out"])).astype(x.dtype)
    return x, (k_new, v_new, logf_new, rw_S_new, p_rw[:, -1:], hg_S_new)


def setup_inputs(seed: int = 0) -> dict:
    key = jax.random.key(seed)
    ks = jax.random.split(key, 40)
    nrm = lambda i, shape, s: s * jax.random.normal(ks[i], shape, F32)
    return {
        "x_prompt": nrm(0, (BATCH, SEQ, D_MODEL), 1.0),
        "x_sample": nrm(1, (DEC_BATCH, DEC_SEQ, D_MODEL), 1.0),
        "c_prompt": nrm(2, (BATCH, D_MODEL), 1.0),
        "c_sample": nrm(3, (DEC_BATCH, D_MODEL), 1.0),
        "cache_fox_k": nrm(4, (DEPTH, DEC_BATCH, PAST_LEN, FOX_HEADS, HEAD_DIM), 1.0),
        "cache_fox_v": nrm(5, (DEPTH, DEC_BATCH, PAST_LEN, FOX_HEADS, HEAD_DIM), 1.0),
        "cache_fox_logf": jax.nn.log_sigmoid(2.0 + nrm(6, (DEPTH, DEC_BATCH, PAST_LEN, FOX_HEADS), 1.0)),
        "state_rwkv": nrm(7, (DEPTH, DEC_BATCH, RW_HEADS, HEAD_DIM, HEAD_DIM), 0.5),
        "state_rwkv_shift": nrm(8, (DEPTH, DEC_BATCH, 1, RW_COLS), 1.0),
        "state_hgrn": nrm(9, (DEPTH, DEC_BATCH, HG_HEADS, HEAD_DIM, HEAD_DIM), 0.5),
        "norm1_g": 1.0 + nrm(10, (DEPTH, D_MODEL), 0.1),
        "w_ada": nrm(11, (DEPTH, D_MODEL, 6 * D_MODEL), 0.5 * D_MODEL ** -0.5),
        "b_ada": nrm(12, (DEPTH, 6 * D_MODEL), 0.1),
        "w_in": nrm(13, (DEPTH, D_MODEL, IN_COLS), D_MODEL ** -0.5),
        "rw_mu": jax.random.uniform(ks[14], (DEPTH, RW_COLS), F32),
        "rw_w0": nrm(15, (DEPTH, RW_WIDTH), 0.5),
        "rw_w2": nrm(16, (DEPTH, RW_W_LORA, RW_WIDTH), RW_W_LORA ** -0.5),
        "rw_a0": nrm(17, (DEPTH, RW_WIDTH), 0.5),
        "rw_a2": nrm(18, (DEPTH, RW_A_LORA, RW_WIDTH), RW_A_LORA ** -0.5),
        "rw_g2": nrm(19, (DEPTH, RW_G_LORA, RW_WIDTH), RW_G_LORA ** -0.5),
        "rw_k_k": 0.85 + nrm(20, (DEPTH, RW_WIDTH), 0.1),
        "rw_k_a": 1.0 + nrm(21, (DEPTH, RW_WIDTH), 0.1),
        "rw_r_k": nrm(22, (DEPTH, RW_HEADS, HEAD_DIM), 0.1),
        "rw_ln_w": 1.0 + nrm(23, (DEPTH, RW_WIDTH), 0.1),
        "rw_ln_b": nrm(24, (DEPTH, RW_WIDTH), 0.01),
        "fox_b_f": 2.0 + nrm(25, (DEPTH, FOX_HEADS), 0.5),
        "hg_lb_logits": nrm(26, (DEPTH, HG_WIDTH), 0.5),
        "hg_norm_g": 1.0 + nrm(27, (DEPTH, HG_WIDTH), 0.1),
        "w_out": nrm(28, (DEPTH, D_MIX, D_MODEL), D_MIX ** -0.5),
        "norm2_g": 1.0 + nrm(29, (DEPTH, D_MODEL), 0.1),
        "w_ffn_in": nrm(30, (DEPTH, D_MODEL, 2 * D_FF), D_MODEL ** -0.5),
        "w_ffn_out": nrm(31, (DEPTH, D_FF, D_MODEL), D_FF ** -0.5),
        "final_norm_g": 1.0 + nrm(32, (D_MODEL,), 0.1),
    }


def reference(x_prompt, x_sample, c_prompt, c_sample, cache_fox_k, cache_fox_v, cache_fox_logf,
              state_rwkv, state_rwkv_shift, state_hgrn, norm1_g, w_ada, b_ada, w_in, rw_mu, rw_w0,
              rw_w2, rw_a0, rw_a2, rw_g2, rw_k_k, rw_k_a, rw_r_k, rw_ln_w, rw_ln_b, fox_b_f,
              hg_lb_logits, hg_norm_g, w_out, norm2_g, w_ffn_in, w_ffn_out, final_norm_g):
    dt = x_prompt.dtype
    lbs = jnp.cumsum(jax.nn.softmax(hg_lb_logits.astype(F32), axis=0), axis=0)
    lbs = lbs - lbs[0:1]
    bp = x_prompt.shape[0]
    rw_prev0 = jnp.zeros((bp, 1, RW_COLS), F32)
    rw_S0 = jnp.zeros((bp, RW_HEADS, HEAD_DIM, HEAD_DIM), F32)
    hg_S0 = jnp.zeros((bp, HG_HEADS, HEAD_DIM, HEAD_DIM), F32)
    xp, xs = x_prompt, x_sample
    outs_p, outs_s = [], []
    for l in range(DEPTH):
        p = {
            "norm1_g": norm1_g[l], "w_ada": w_ada[l], "b_ada": b_ada[l], "w_in": w_in[l],
            "rw": (rw_mu[l], rw_w0[l], rw_w2[l], rw_a0[l], rw_a2[l], rw_g2[l], rw_k_k[l], rw_k_a[l],
                   rw_r_k[l], rw_ln_w[l], rw_ln_b[l]),
            "fox_b_f": fox_b_f[l], "hg_lb": lbs[l], "hg_norm_g": hg_norm_g[l], "w_out": w_out[l],
            "norm2_g": norm2_g[l], "w_ffn_in": w_ffn_in[l], "w_ffn_out": w_ffn_out[l],
        }
        xp, st_p = trunk_layer(xp, c_prompt, p, rw_prev0, rw_S0, hg_S0, (None, None, None), CHUNK)
        xs, st_s = trunk_layer(xs, c_sample, p, state_rwkv_shift[l], state_rwkv[l], state_hgrn[l],
                               (cache_fox_k[l], cache_fox_v[l], cache_fox_logf[l]), xs.shape[1])
        outs_p.append(st_p)
        outs_s.append(st_s)
    stk = lambda outs, j: jnp.stack([o[j] for o in outs], axis=0).astype(dt)
    y_prompt = rmsnorm(xp, final_norm_g).astype(dt)
    y_sample = rmsnorm(xs, final_norm_g).astype(dt)
    return (y_prompt, y_sample,
            stk(outs_p, 0), stk(outs_p, 1), stk(outs_p, 2), stk(outs_p, 3), stk(outs_p, 4), stk(outs_p, 5),
            stk(outs_s, 0), stk(outs_s, 1), stk(outs_s, 2), stk(outs_s, 3), stk(outs_s, 4), stk(outs_s, 5))
```

```cpp
#include <hip/hip_runtime.h>
#include <hip/hip_cooperative_groups.h>
#include <cstdio>
#include <cstdint>
#include <cmath>
#include <cstddef>
namespace cg = cooperative_groups;

#ifndef ONE_LAUNCH
#define ONE_LAUNCH 1
#endif

constexpr int DM = 1024, NB = 16, SEQ = 4096, DEPTH = 4, DB = 8, DSEQ = 32, PAST = 2048;
constexpr int MP = NB * SEQ, MS = DB * DSEQ, MROWS = MP + MS;
constexpr int NSEQ = NB + DB;
constexpr int RWC = 896, INC = 3464, NIN = 3584, DFF = 2816, NFI = 5632;
constexpr int NWAVES = 8, NTHR = 512;
constexpr int LDS_BYTES = 147456;
constexpr float LOG2E = 1.4426950408889634f;
constexpr float QSCALE = 0.125f * LOG2E;

constexpr size_t O_YP = 0;
constexpr size_t O_YS = O_YP + (size_t)MP * DM;
constexpr size_t O_KP = O_YS + (size_t)MS * DM;
constexpr size_t SZ_KP = (size_t)NB * SEQ * 512;
constexpr size_t O_VP = O_KP + DEPTH * SZ_KP;
constexpr size_t O_LFP = O_VP + DEPTH * SZ_KP;
constexpr size_t SZ_LFP = (size_t)NB * SEQ * 8;
constexpr size_t O_RSP = O_LFP + DEPTH * SZ_LFP;
constexpr size_t SZ_RSP = (size_t)NB * 4 * 64 * 64;
constexpr size_t O_SHP = O_RSP + DEPTH * SZ_RSP;
constexpr size_t SZ_SHP = (size_t)NB * RWC;
constexpr size_t O_HSP = O_SHP + DEPTH * SZ_SHP;
constexpr size_t O_KS = O_HSP + DEPTH * SZ_RSP;
constexpr size_t SZ_KS = (size_t)DB * DSEQ * 512;
constexpr size_t O_VS = O_KS + DEPTH * SZ_KS;
constexpr size_t O_LFS = O_VS + DEPTH * SZ_KS;
constexpr size_t SZ_LFS = (size_t)DB * DSEQ * 8;
constexpr size_t O_RSS = O_LFS + DEPTH * SZ_LFS;
constexpr size_t SZ_RSS = (size_t)DB * 4 * 64 * 64;
constexpr size_t O_SHS = O_RSS + DEPTH * SZ_RSS;
constexpr size_t SZ_SHS = (size_t)DB * RWC;
constexpr size_t O_HSS = O_SHS + DEPTH * SZ_SHS;
constexpr size_t O_END = O_HSS + DEPTH * SZ_RSS;
static_assert(O_END == 342192128ull, "d_out map");

constexpr size_t al256(size_t x) { return (x + 255) & ~(size_t)255; }
constexpr size_t WS_MOD = 0;
constexpr size_t WS_LBS = al256(WS_MOD + (size_t)DEPTH * NSEQ * 6144 * 4);
constexpr size_t WS_WIN = al256(WS_LBS + (size_t)DEPTH * 256 * 4);
constexpr size_t WS_WOUT = al256(WS_WIN + (size_t)DEPTH * NIN * DM * 2);
constexpr size_t WS_WFI = al256(WS_WOUT + (size_t)DEPTH * DM * DM * 2);
constexpr size_t WS_WFO = al256(WS_WFI + (size_t)DEPTH * NFI * DM * 2);
constexpr size_t WS_CB = al256(WS_WFO + (size_t)DEPTH * DM * DFF * 2);
constexpr size_t WS_CBS = al256(WS_CB + (size_t)128 * 4096 * 4);
constexpr size_t WS_BON = al256(WS_CBS + (size_t)64 * 2112 * 4);
constexpr size_t WS_HB = al256(WS_BON + (size_t)MROWS * 4 * 4);
constexpr size_t WS_OHG = al256(WS_HB + (size_t)MROWS * DM * 2);
constexpr size_t WS_W = al256(WS_OHG + (size_t)MROWS * 256 * 4);
constexpr size_t WS_Q = al256(WS_W + (size_t)MROWS * 256 * 4);
constexpr size_t WS_PRW = al256(WS_Q + (size_t)MROWS * 512 * 2);
constexpr size_t WS_PHG = al256(WS_PRW + (size_t)MROWS * RWC * 2);
constexpr size_t WS_R = al256(WS_PHG + (size_t)MROWS * DM * 2);
constexpr size_t SZ_OP = al256((size_t)MROWS * 256 * 2);
constexpr size_t WS_END = WS_R + 6 * SZ_OP;
constexpr size_t WS_KN = WS_END + 4096;
constexpr size_t WS_CNT = WS_END + 8192;
constexpr size_t WS_KNE = WS_END + 16384;
constexpr size_t WS_KNC = WS_END + 24576;
constexpr size_t WS_END2 = WS_END + 32768;
constexpr size_t WS_MID = WS_Q;
static_assert(WS_MID + (size_t)MROWS * DFF * 2 <= WS_END, "MID overlay");

typedef unsigned short bf16_t;
typedef short bf16x8 __attribute__((ext_vector_type(8)));
typedef short s16x4 __attribute__((ext_vector_type(4)));
typedef float f32x4 __attribute__((ext_vector_type(4)));
typedef float f32x2 __attribute__((ext_vector_type(2)));
typedef float f32x16 __attribute__((ext_vector_type(16)));
typedef unsigned u32x4 __attribute__((ext_vector_type(4)));
typedef unsigned u32x2 __attribute__((ext_vector_type(2)));
typedef __bf16 bf16x2_t __attribute__((ext_vector_type(2)));
#define LAS __attribute__((address_space(3)))
#define DI __device__ __forceinline__

DI unsigned pk2(float lo, float hi) { f32x2 v = {lo, hi}; bf16x2_t b = __builtin_convertvector(v, bf16x2_t); return __builtin_bit_cast(unsigned, b); }
DI float bf2f(unsigned short b) { return __uint_as_float(((unsigned)b) << 16); }
DI float bflo(unsigned w) { return __uint_as_float(w << 16); }
DI float bfhi(unsigned w) { return __uint_as_float(w & 0xffff0000u); }
DI u32x4 pack8(f32x4 a, f32x4 b) { u32x4 w; w.x = pk2(a[0], a[1]); w.y = pk2(a[2], a[3]); w.z = pk2(b[0], b[1]); w.w = pk2(b[2], b[3]); return w; }
DI u32x2 pack4(f32x4 a) { u32x2 w; w.x = pk2(a[0], a[1]); w.y = pk2(a[2], a[3]); return w; }
DI f32x4 unpack4(u32x2 w) { return (f32x4){bflo(w.x), bfhi(w.x), bflo(w.y), bfhi(w.y)}; }
DI float sigmoidf_(float x) { return __builtin_amdgcn_rcpf(1.0f + __expf(-x)); }
DI float siluf_(float x) { return x * __builtin_amdgcn_rcpf(1.0f + __expf(-x)); }
DI float log_sigmoidf_(float x) { return fminf(x, 0.f) - log1pf(__expf(-fabsf(x))); }
DI float softplusf_(float x) { return fmaxf(x, 0.f) + log1pf(__expf(-fabsf(x))); }
DI float wave_sum(float v) {
#pragma unroll
    for (int o = 1; o < 64; o <<= 1) v += __shfl_xor(v, o);
    return v;
}
template <int CTRL> DI float dpp_add(float x) { const int y = __builtin_amdgcn_update_dpp(0, __float_as_int(x), CTRL, 0xF, 0xF, true); return x + __int_as_float(y); }
DI float row16_sum(float x) { x = dpp_add<0xB1>(x); x = dpp_add<0x4E>(x); x = dpp_add<0x124>(x); x = dpp_add<0x128>(x); return x; }
DI float wave_sum_fast(float x) { x = row16_sum(x); x += __shfl_xor(x, 16); x += __shfl_xor(x, 32); return x; }
DI int row_seq(int row) { return row < MP ? (row >> 12) : NB + ((row - MP) >> 5); }

struct Args {
    const float* in[33];
    float* out;
    unsigned char* ws;
    int ph_lo, ph_hi;
};


#define AS4 __attribute__((address_space(4)))
DI unsigned long long ka_u64(int off) { const AS4 unsigned char* p = (const AS4 unsigned char*)__builtin_amdgcn_kernarg_segment_ptr(); asm volatile("" : "+s"(p)); return *(const AS4 unsigned long long*)(p + off); }
#define AS1 __attribute__((address_space(1)))
DI const float* A_in(int i) { return (const float*)(const AS1 float*)ka_u64(8 * i); }
DI float* A_out() { return (float*)(AS1 float*)ka_u64(264); }
DI unsigned char* A_ws() { return (unsigned char*)(AS1 unsigned char*)ka_u64(272); }
DI int otid_(int wvs) { int t = (wvs << 6) | (int)__builtin_amdgcn_mbcnt_hi(~0u, __builtin_amdgcn_mbcnt_lo(~0u, 0u)); asm volatile("" : "+v"(t)); return t; }
#define otid() otid_(wvs__)
DI int obid() { int b = blockIdx.x; asm volatile("" : "+s"(b)); return b; }
static_assert(offsetof(Args, out) == 264 && offsetof(Args, ws) == 272 && sizeof(Args) == 288, "Args layout");

namespace pg8 {
#define PG8_LAS __attribute__((address_space(3)))
typedef unsigned short bf16_t;
typedef short bf16x8 __attribute__((ext_vector_type(8)));
typedef float f32x4 __attribute__((ext_vector_type(4)));
typedef unsigned u32x4 __attribute__((ext_vector_type(4)));
constexpr int BM = 256, BK = 64, HALF = 128, HTB = HALF * BK * 2  , STAGE_BYTES = 8 * HTB, NXCD = 8, WGM = 8;

__host__ __device__ __forceinline__ int lds_byte(int r, int c) { const int st = (r >> 4) * 2 + (c >> 5), rr = r & 15, cc = c & 31, ob = rr * 64 + cc * 2; return st * 1024 + (ob ^ (((ob >> 9) & 1) << 5)); }
__host__ __device__ __forceinline__ void stage_rc(int b, int& R, int& C) { const int st = b / 1024, sb = b % 1024, swz = sb ^ (((sb >> 9) & 1) << 5); R = (st >> 1) * 16 + swz / 64; C = (st & 1) * 32 + (swz % 64) / 2; }
__host__ __device__ __forceinline__ int perm32(int rho) { const int n = rho >> 4, i = rho & 15; return 8 * (i >> 2) + 4 * n + (i & 3); }

struct Unit { int pm, pn; };
struct Gemm { const bf16_t* A; const bf16_t* Bt; int M, N, K; };

struct StaticOrder {
    int nM, nN, nwg, G, c;
    __host__ __device__ void init(int M, int N, int G_, int c_) { nM = M / BM; nN = N / BM; nwg = nM * nN; G = G_; c = c_; }
    __host__ __device__ bool next(int i, Unit& u) const {
        const long L = (long)i * G + c; if (L >= nwg) return false;
        int wgid = (int)L; { const int q = nwg / NXCD, r = nwg % NXCD, xcd = wgid % NXCD, off = wgid / NXCD; wgid = (xcd < r ? xcd * (q + 1) : r * (q + 1) + (xcd - r) * q) + off; }
        const int nig = WGM * nN, gid = wgid / nig, fm = gid * WGM, gsz = (nM - fm) < WGM ? (nM - fm) : WGM;
        u.pm = fm + ((wgid % nig) % gsz); u.pn = (wgid % nig) / gsz; return true;
    }
    __device__ __forceinline__ void a_ready(const Unit&) const {}
    __device__ __forceinline__ void done(const Unit&) const {}
};
template <class Epi, class Sched, bool ALIGN_EPI = false, bool SP2 = false>
__device__ __forceinline__ void gemm_phase(PG8_LAS unsigned char* lds, const Gemm g, const Sched& S, const Epi& E, int wvs__) {
    const int tid = otid(), wid = __builtin_amdgcn_readfirstlane(tid >> 6), lane = tid & 63, wr = wid >> 2, wc = wid & 3, fr = lane & 15, fq = lane >> 4;
    const int K = g.K, nt = K / BK;
    unsigned voffA[2], voffB[2];
#pragma unroll
    for (int i = 0; i < 2; ++i) { int R, C; stage_rc(tid * 16 + i * 8192, R, C); const int Rb = Epi::PERM ? ((R & ~31) + perm32(R & 31)) : R;
        voffA[i] = (unsigned)(R * K + C) * 2u; voffB[i] = (unsigned)(Rb * K + C) * 2u; }
    const size_t kstep = (size_t)(BK * 2);
    const size_t hstep = (size_t)HALF * K * 2;
    const size_t tstep = 2 * hstep;
    const unsigned ldsw = (unsigned)wid * 1024u;
    const int aoff = lds_byte(wr * 64 + fr, fq * 8), boff = lds_byte(wc * 32 + fr, fq * 8);
#define PG8_SA(b, h) (((b) * 2 + (h)) * HTB)
#define PG8_SB(b, h) ((4 + (b) * 2 + (h)) * HTB)
#define PG8_STAGE(bufoff, gbase, voff) do { _Pragma("unroll") for (int _i = 0; _i < 2; ++_i) \
        __builtin_amdgcn_global_load_lds((const unsigned*)((const char*)(gbase) + (voff)[_i]), (PG8_LAS unsigned*)(lds + (bufoff) + ldsw + _i * 8192), 16, 0, 0); } while (0)
#define PG8_LDA(dst, b, h) do { _Pragma("unroll") for (int m = 0; m < 4; ++m) _Pragma("unroll") for (int k = 0; k < 2; ++k) dst[m][k] = *(const PG8_LAS bf16x8*)(lds + PG8_SA(b, h) + aoff + m * 2048 + k * 1024); } while (0)
#define PG8_LDB(dst, b, h) do { _Pragma("unroll") for (int n = 0; n < 2; ++n) _Pragma("unroll") for (int k = 0; k < 2; ++k) dst[n][k] = *(const PG8_LAS bf16x8*)(lds + PG8_SB(b, h) + boff + n * 2048 + k * 1024); } while (0)
#define PG8_MMA(ai, bj, At, Bt) do { __builtin_amdgcn_s_setprio(1); _Pragma("unroll") for (int m = 0; m < 4; ++m) _Pragma("unroll") for (int n = 0; n < 2; ++n) _Pragma("unroll") for (int k = 0; k < 2; ++k) \
        acc[ai][bj][m][n] = __builtin_amdgcn_mfma_f32_16x16x32_bf16(Bt[n][k], At[m][k], acc[ai][bj][m][n], 0, 0, 0); __builtin_amdgcn_s_setprio(0); } while (0)
#define PG8_WAIT_V(n) asm volatile("s_waitcnt vmcnt(" #n ")" ::: "memory")
#define PG8_WAIT_L(n) asm volatile("s_waitcnt lgkmcnt(" #n ")" ::: "memory")
#define PG8_BAR __builtin_amdgcn_s_barrier()
#define PG8_SCHED __builtin_amdgcn_sched_barrier(0)
    Unit cur, nxt; int ui = 0;
    if (!S.next(0, cur)) return;
    f32x4 acc[2][2][4][2];
#pragma unroll
    for (int a = 0; a < 2; ++a)
#pragma unroll
        for (int b = 0; b < 2; ++b)
#pragma unroll
            for (int m = 0; m < 4; ++m)
#pragma unroll
                for (int n = 0; n < 2; ++n) acc[a][b][m][n] = (f32x4){0.f, 0.f, 0.f, 0.f};
    bf16x8 At[4][2], B0[2][2], B1[2][2];
    const char* cA = (const char*)g.A + (size_t)cur.pm * tstep; const char* cB = (const char*)g.Bt + (size_t)cur.pn * tstep;
    S.a_ready(cur);
    if constexpr (SP2) {
        PG8_STAGE(PG8_SB(0, 0), cB, voffB); PG8_STAGE(PG8_SB(0, 1), cB + hstep, voffB); PG8_STAGE(PG8_SA(0, 0), cA, voffA); PG8_STAGE(PG8_SA(0, 1), cA + hstep, voffA);
        if (wr == 1) PG8_BAR;
        PG8_WAIT_V(2); PG8_BAR;
        PG8_STAGE(PG8_SB(1, 0), cB + kstep, voffB); PG8_STAGE(PG8_SA(1, 0), cA + kstep, voffA); PG8_STAGE(PG8_SB(1, 1), cB + hstep + kstep, voffB);
        PG8_WAIT_V(6); PG8_BAR;
    } else {
        PG8_STAGE(PG8_SB(0, 0), cB, voffB); PG8_STAGE(PG8_SA(0, 0), cA, voffA); PG8_STAGE(PG8_SB(0, 1), cB + hstep, voffB); PG8_STAGE(PG8_SA(0, 1), cA + hstep, voffA);
        if (wr == 1) PG8_BAR;
        PG8_WAIT_V(4); PG8_BAR;
        PG8_STAGE(PG8_SB(1, 0), cB + kstep, voffB); PG8_STAGE(PG8_SA(1, 0), cA + kstep, voffA); PG8_STAGE(PG8_SB(1, 1), cB + hstep + kstep, voffB);
        PG8_WAIT_V(6); PG8_BAR;
    }
    for (;;) {
        const bool has_next = S.next(ui + 1, nxt);
        const char* nA = has_next ? (const char*)g.A + (size_t)nxt.pm * tstep : cA; const char* nB = has_next ? (const char*)g.Bt + (size_t)nxt.pn * tstep : cB;
        for (int t = 0; t < nt; t += 2) {
            const bool last = (t == nt - 2);
            const char* a1 = cA + (size_t)(t + 1) * kstep;
            const char* a2 = last ? nA : cA + (size_t)(t + 2) * kstep; const char* b2 = last ? nB : cB + (size_t)(t + 2) * kstep;
            const char* a3 = a2 + kstep; const char* b3 = b2 + kstep;
            if (last && has_next) S.a_ready(nxt);
            if constexpr (SP2) {
            PG8_LDB(B0, 0, 0); PG8_LDB(B1, 0, 1); PG8_SCHED; PG8_LDA(At, 0, 0); PG8_STAGE(PG8_SA(1, 1), a1 + hstep, voffA);
            PG8_WAIT_V(8); PG8_WAIT_L(0); PG8_BAR; PG8_MMA(0, 0, At, B0); PG8_MMA(0, 1, At, B1); PG8_BAR; PG8_SCHED;
            PG8_LDA(At, 0, 1); PG8_STAGE(PG8_SB(0, 0), b2, voffB); PG8_STAGE(PG8_SB(0, 1), b2 + hstep, voffB); PG8_STAGE(PG8_SA(0, 0), a2, voffA);
            PG8_WAIT_V(8); PG8_WAIT_L(0); PG8_BAR; PG8_MMA(1, 0, At, B0); PG8_MMA(1, 1, At, B1); PG8_BAR; PG8_SCHED;
            PG8_LDB(B0, 1, 0); PG8_LDB(B1, 1, 1); PG8_SCHED; PG8_LDA(At, 1, 0); PG8_STAGE(PG8_SA(0, 1), a2 + hstep, voffA);
            PG8_WAIT_V(8); PG8_WAIT_L(0); PG8_BAR; PG8_MMA(0, 0, At, B0); PG8_MMA(0, 1, At, B1); PG8_BAR; PG8_SCHED;
            PG8_LDA(At, 1, 1); PG8_STAGE(PG8_SB(1, 0), b3, voffB); PG8_STAGE(PG8_SB(1, 1), b3 + hstep, voffB); PG8_STAGE(PG8_SA(1, 0), a3, voffA);
            PG8_WAIT_V(8); PG8_WAIT_L(0); PG8_BAR; PG8_MMA(1, 0, At, B0); PG8_MMA(1, 1, At, B1); PG8_BAR; PG8_SCHED;
            } else {
            PG8_LDB(B0, 0, 0); PG8_SCHED; PG8_LDA(At, 0, 0); PG8_STAGE(PG8_SA(1, 1), a1 + hstep, voffA);
            PG8_WAIT_L(8); PG8_BAR; PG8_WAIT_L(0); PG8_MMA(0, 0, At, B0); PG8_BAR; PG8_SCHED;
            PG8_LDB(B1, 0, 1); PG8_STAGE(PG8_SB(0, 0), b2, voffB);
            PG8_BAR; PG8_WAIT_L(0); PG8_MMA(0, 1, At, B1); PG8_BAR;
            PG8_LDA(At, 0, 1); PG8_STAGE(PG8_SA(0, 0), a2, voffA);
            PG8_BAR; PG8_WAIT_L(0); PG8_MMA(1, 0, At, B0); PG8_BAR; PG8_SCHED;
            PG8_STAGE(PG8_SB(0, 1), b2 + hstep, voffB);
            PG8_WAIT_V(6); PG8_BAR; PG8_MMA(1, 1, At, B1); PG8_BAR;
            PG8_LDB(B0, 1, 0); PG8_SCHED; PG8_LDA(At, 1, 0); PG8_STAGE(PG8_SA(0, 1), a2 + hstep, voffA);
            PG8_WAIT_L(8); PG8_BAR; PG8_WAIT_L(0); PG8_MMA(0, 0, At, B0); PG8_BAR; PG8_SCHED;
            PG8_LDB(B1, 1, 1); PG8_STAGE(PG8_SB(1, 0), b3, voffB);
            PG8_BAR; PG8_WAIT_L(0); PG8_MMA(0, 1, At, B1); PG8_BAR;
            PG8_LDA(At, 1, 1); PG8_STAGE(PG8_SA(1, 0), a3, voffA);
            PG8_BAR; PG8_WAIT_L(0); PG8_MMA(1, 0, At, B0); PG8_BAR; PG8_SCHED;
            PG8_STAGE(PG8_SB(1, 1), b3 + hstep, voffB);
            PG8_WAIT_V(6); PG8_BAR; PG8_MMA(1, 1, At, B1); PG8_BAR;
            }
        }
        if constexpr (ALIGN_EPI) { if (wr == 0) PG8_BAR; }
        if constexpr (!Epi::AFTER_DRAIN) { E(acc, cur, wr, wc, fr, fq); S.done(cur); }
        if (!has_next) break;
#pragma unroll
        for (int a = 0; a < 2; ++a)
#pragma unroll
            for (int b = 0; b < 2; ++b)
#pragma unroll
                for (int m = 0; m < 4; ++m)
#pragma unroll
                    for (int n = 0; n < 2; ++n) acc[a][b][m][n] = (f32x4){0.f, 0.f, 0.f, 0.f};
        cur = nxt; cA = nA; cB = nB; ++ui;
        if constexpr (ALIGN_EPI) { if (wr == 1) PG8_BAR; }
    }
    PG8_WAIT_V(0);
    if constexpr (!ALIGN_EPI) { if (wr == 0) PG8_BAR; }
    PG8_BAR;
    if constexpr (Epi::AFTER_DRAIN) { E.fused(acc, cur, wr, wc, fr, fq, lds, wid, lane); S.done(cur); }
#undef PG8_SA
#undef PG8_SB
#undef PG8_STAGE
#undef PG8_LDA
#undef PG8_LDB
#undef PG8_MMA
#undef PG8_WAIT_V
#undef PG8_WAIT_L
#undef PG8_BAR
#undef PG8_SCHED
}
}

namespace pg8 {
struct EpiIn {
    static constexpr bool PERM = true, AFTER_DRAIN = false;
    int l;
    __device__ __forceinline__ void operator()(const f32x4 (&acc)[2][2][4][2], const Unit& u, int wr, int wc, int fr, int fq) const {
        const int pn = u.pn;
        unsigned char* ws_ = A_ws(); float* out_ = A_out();
        bf16_t* Q = (bf16_t*)(ws_ + WS_Q); bf16_t* PRW = (bf16_t*)(ws_ + WS_PRW); bf16_t* PHG = (bf16_t*)(ws_ + WS_PHG);
        float* Kp = out_ + O_KP + (size_t)l * SZ_KP; float* Vp = out_ + O_VP + (size_t)l * SZ_KP; float* LFp = out_ + O_LFP + (size_t)l * SZ_LFP; float* SHp = out_ + O_SHP + (size_t)l * SZ_SHP;
        float* Ks = out_ + O_KS + (size_t)l * SZ_KS; float* Vs = out_ + O_VS + (size_t)l * SZ_KS; float* LFs = out_ + O_LFS + (size_t)l * SZ_LFS; float* SHs = out_ + O_SHS + (size_t)l * SZ_SHS;
        const float* bf = A_in(25) + l * 8;
        float kmx[2] = {0.f, 0.f};
#pragma unroll
        for (int ai = 0; ai < 2; ++ai)
#pragma unroll
            for (int m = 0; m < 4; ++m) {
                const int row = u.pm * BM + ai * HALF + wr * 64 + m * 16 + fr;
                const bool samp = row >= MP;
#pragma unroll
                for (int bj = 0; bj < 2; ++bj) {
                    const int col0 = pn * BM + bj * HALF + wc * 32 + 8 * fq;
                    const f32x4 v0 = acc[ai][bj][m][0], v1 = acc[ai][bj][m][1];
                    if (pn < 2) {
                        *(u32x4*)(Q + (size_t)row * 512 + col0) = pack8(v0 * QSCALE, v1 * QSCALE);
                    } else if (pn < 4) {
                        float* d = (samp ? Ks + (size_t)(row - MP) * 512 : Kp + (size_t)row * 512) + (col0 - 512);
                        *(f32x4*)d = v0; *(f32x4*)(d + 4) = v1;
                        float sq = ((v0[0] * v0[0] + v0[1] * v0[1]) + (v0[2] * v0[2] + v0[3] * v0[3])) + ((v1[0] * v1[0] + v1[1] * v1[1]) + (v1[2] * v1[2] + v1[3] * v1[3]));
                        sq += __shfl_xor(sq, 16); sq += __shfl_xor(sq, 32);
                        if (u.pm < MP / BM) kmx[bj] = fmaxf(kmx[bj], sq);
                        else {
#pragma unroll
                            for (int o = 1; o < 16; o <<= 1) sq = fmaxf(sq, __shfl_xor(sq, o));
                            if (fr == 0 && fq == 0) atomicMax((unsigned*)(ws_ + WS_KNE) + ((l * NSEQ + NB + ai * 4 + wr * 2 + (m >> 1)) * 8 + 4 * (pn - 2) + 2 * bj + (wc >> 1)) * 2 + (wc & 1), __float_as_uint(sq));
                        }
                    } else if (pn < 6) {
                        float* d = (samp ? Vs + (size_t)(row - MP) * 512 : Vp + (size_t)row * 512) + (col0 - 1024);
                        *(f32x4*)d = v0; *(f32x4*)(d + 4) = v1;
                    } else if (pn < 10) {
                        *(u32x4*)(PHG + (size_t)row * 1024 + (col0 - 1536)) = pack8(v0, v1);
                    } else {
                        const int c = col0 - 2560;
                        if (c < RWC) {
                            *(u32x4*)(PRW + (size_t)row * RWC + c) = pack8(v0, v1);
                            const bool last = samp ? (((row - MP) & 31) == 31) : ((row & 4095) == 4095);
                            if (last) { float* d = (samp ? SHs + (size_t)((row - MP) >> 5) * RWC : SHp + (size_t)(row >> 12) * RWC) + c; *(f32x4*)d = v0; *(f32x4*)(d + 4) = v1; }
                        } else if (c == RWC) {
                            f32x4 l0, l1;
#pragma unroll
                            for (int j = 0; j < 4; ++j) { l0[j] = log_sigmoidf_(v0[j] + bf[j]); l1[j] = log_sigmoidf_(v1[j] + bf[4 + j]); }
                            float* d = samp ? LFs + (size_t)(row - MP) * 8 : LFp + (size_t)row * 8;
                            *(f32x4*)d = l0; *(f32x4*)(d + 4) = l1;
                        }
                    }
                }
            }
        if (pn >= 2 && pn < 4 && u.pm < MP / BM) {
#pragma unroll
            for (int bj = 0; bj < 2; ++bj) {
                float mx = kmx[bj];
#pragma unroll
                for (int o = 1; o < 16; o <<= 1) mx = fmaxf(mx, __shfl_xor(mx, o));
                if (fr == 0 && fq == 0) atomicMax((unsigned*)(ws_ + WS_KNE) + ((l * NSEQ + (u.pm >> 4)) * 8 + 4 * (pn - 2) + 2 * bj + (wc >> 1)) * 2 + (wc & 1), __float_as_uint(mx));
            }
        }
    }
};
struct EpiRes {
    static constexpr bool PERM = false, AFTER_DRAIN = false;
    const float* xin_p; const float* xin_s; float* xout; const float* ga;
    __device__ __forceinline__ void operator()(const f32x4 (&acc)[2][2][4][2], const Unit& u, int wr, int wc, int fr, int fq) const {
        const float* gr = ga + (size_t)(u.pm >> 4) * 6144 + u.pn * BM + wc * 32 + 4 * fq;
        f32x4 g4[2][2];
#pragma unroll
        for (int bj = 0; bj < 2; ++bj)
#pragma unroll
            for (int n = 0; n < 2; ++n) g4[bj][n] = *(const f32x4*)(gr + bj * HALF + 16 * n);
        const size_t off0 = (size_t)(u.pm * BM + wr * 64 + fr) * DM + u.pn * BM + wc * 32 + 4 * fq;
        f32x4 xc[2][2], xn[2][2];
#pragma unroll
        for (int bj = 0; bj < 2; ++bj)
#pragma unroll
            for (int n = 0; n < 2; ++n) xc[bj][n] = *(const f32x4*)(xin_p + off0 + bj * HALF + 16 * n);
#pragma unroll
        for (int gi = 0; gi < 8; ++gi) {
            const int ai = gi >> 2, m = gi & 3;
            const size_t off = off0 + (size_t)(ai * HALF + m * 16) * DM;
            if (gi + 1 < 8) {
                const size_t offn = off0 + (size_t)(((gi + 1) >> 2) * HALF + ((gi + 1) & 3) * 16) * DM;
#pragma unroll
                for (int bj = 0; bj < 2; ++bj)
#pragma unroll
                    for (int n = 0; n < 2; ++n) xn[bj][n] = *(const f32x4*)(xin_p + offn + bj * HALF + 16 * n);
            }
#pragma unroll
            for (int bj = 0; bj < 2; ++bj)
#pragma unroll
                for (int n = 0; n < 2; ++n) { *(f32x4*)(xout + off + bj * HALF + 16 * n) = xc[bj][n] + g4[bj][n] * acc[ai][bj][m][n]; xc[bj][n] = xn[bj][n]; }
        }
    }
};
struct EpiSwiglu {
    static constexpr bool PERM = true, AFTER_DRAIN = false;
    bf16_t* O;
    __device__ __forceinline__ void operator()(const f32x4 (&acc)[2][2][4][2], const Unit& u, int wr, int wc, int fr, int fq) const {
        const int col0 = u.pn * HALF + wc * 32 + 8 * fq;
#pragma unroll
        for (int ai = 0; ai < 2; ++ai)
#pragma unroll
            for (int m = 0; m < 4; ++m) {
                const int row = u.pm * BM + ai * HALF + wr * 64 + m * 16 + fr;
                f32x4 o0, o1;
#pragma unroll
                for (int j = 0; j < 4; ++j) { o0[j] = siluf_(acc[ai][0][m][0][j]) * acc[ai][1][m][0][j]; o1[j] = siluf_(acc[ai][0][m][1][j]) * acc[ai][1][m][1][j]; }
                *(u32x4*)(O + (size_t)row * DFF + col0) = pack8(o0, o1);
            }
    }
};
}

DI void transpose_item(const float* W, int K, int N, bf16_t* WT, int src_n0, int ncols, int dst_row0, int kb, float* scr, int lane) {
    const int k0 = 64 * kb;
    const int nl = lane & 31;
#pragma unroll
    for (int i = 0; i < 32; ++i) { const int kk = 2 * i + (lane >> 5); scr[kk * 33 + nl] = (nl < ncols) ? W[(size_t)(k0 + kk) * N + src_n0 + nl] : 0.f; }
    asm volatile("s_waitcnt lgkmcnt(0)" ::: "memory");
    const int c = lane & 7;
#pragma unroll
    for (int j = 0; j < 4; ++j) {
        const int n = (lane >> 3) + 8 * j; const float* s = scr + (8 * c) * 33 + n;
        u32x4 o; o.x = pk2(s[0 * 33], s[1 * 33]); o.y = pk2(s[2 * 33], s[3 * 33]); o.z = pk2(s[4 * 33], s[5 * 33]); o.w = pk2(s[6 * 33], s[7 * 33]);
        if (n < ncols) *(u32x4*)(WT + (size_t)(dst_row0 + n) * K + k0 + 8 * c) = o;
    }
    asm volatile("s_waitcnt lgkmcnt(0)" ::: "memory");
}

DI void phase_prologue(const Args& A, unsigned char* lds, int wvs__) {
    const int tid = otid(), lane = tid & 63, wave = tid >> 6;
    const int gw = obid() * NWAVES + wave, NGW = gridDim.x * NWAVES;
    float* scr = (float*)(lds + wave * 8448);
    constexpr int I_IN = 109 * 16, I_OUT = 32 * 16, I_FI = 176 * 16, I_FO = 32 * 44, I_L = I_IN + I_OUT + I_FI + I_FO;
    for (int it = gw; it < DEPTH * I_L; it += NGW) {
        const int l = it / I_L; int r = it % I_L;
        if (r < I_IN) {
            const int cbi = r / 16, kb = r % 16; int src, dst, nc = 32;
            if (cbi < 16) { src = 896 + 32 * cbi; dst = 32 * cbi; }
            else if (cbi < 32) { src = 1408 + 32 * (cbi - 16); dst = 512 + 32 * (cbi - 16); }
            else if (cbi < 48) { src = 1920 + 32 * (cbi - 32); dst = 1024 + 32 * (cbi - 32); }
            else if (cbi < 80) { src = 2440 + 32 * (cbi - 48); dst = 1536 + 32 * (cbi - 48); }
            else if (cbi < 108) { src = 32 * (cbi - 80); dst = 2560 + 32 * (cbi - 80); }
            else { src = 2432; dst = 3456; nc = 8; }
            transpose_item(A_in(13) + (size_t)l * DM * INC, DM, INC, (bf16_t*)(A_ws() + WS_WIN) + (size_t)l * NIN * DM, src, nc, dst, kb, scr, lane);
            continue;
        }
        r -= I_IN;
        if (r < I_OUT) {
            const int cbi = r / 16, kb = r % 16;
            transpose_item(A_in(28) + (size_t)l * DM * DM, DM, DM, (bf16_t*)(A_ws() + WS_WOUT) + (size_t)l * DM * DM, 32 * cbi, 32, 32 * cbi, kb, scr, lane);
            continue;
        }
        r -= I_OUT;
        if (r < I_FI) {
            const int cbi = r / 16, kb = r % 16; const int n0 = 32 * cbi;
            int dst; if (n0 < DFF) dst = (n0 / 128) * 256 + (n0 % 128); else { const int j = n0 - DFF; dst = (j / 128) * 256 + 128 + (j % 128); }
            transpose_item(A_in(30) + (size_t)l * DM * NFI, DM, NFI, (bf16_t*)(A_ws() + WS_WFI) + (size_t)l * NFI * DM, n0, 32, dst, kb, scr, lane);
            continue;
        }
        r -= I_FI;
        { const int cbi = r / 44, kb = r % 44;
          transpose_item(A_in(31) + (size_t)l * DFF * DM, DFF, DM, (bf16_t*)(A_ws() + WS_WFO) + (size_t)l * DM * DFF, 32 * cbi, 32, 32 * cbi, kb, scr, lane); }
    }
    __syncthreads();
    if (obid() == 0 && tid < 4) ((unsigned*)(A_ws() + WS_CNT))[tid] = 0u;
    if (obid() == 0) for (int e = tid; e < DEPTH * NSEQ * 16; e += NTHR) ((float*)(A_ws() + WS_KNE))[e] = 0.f;
    for (int it = obid(); it < DEPTH * 64; it += gridDim.x) {
        float* red = (float*)lds;
        const int l = it >> 6, b = (it >> 3) & 7, h = it & 7;
        const float* ka = A_in(4) + ((size_t)l * DB + b) * PAST * 512 + h * 64;
        float mx = 0.f;
#pragma unroll 8
        for (int e = tid; e < PAST * 16; e += NTHR) {
            const f32x4 v = *(const f32x4*)(ka + (size_t)(e >> 4) * 512 + 4 * (e & 15));
            mx = fmaxf(mx, row16_sum((v[0] * v[0] + v[1] * v[1]) + (v[2] * v[2] + v[3] * v[3])));
        }
#pragma unroll
        for (int o = 1; o < 64; o <<= 1) mx = fmaxf(mx, __shfl_xor(mx, o));
        if (lane == 0) red[wave] = mx;
        __syncthreads();
        if (tid == 0) { float m = red[0]; for (int w = 1; w < 8; ++w) m = fmaxf(m, red[w]); ((float*)(A_ws() + WS_KNC))[it] = m; }
        __syncthreads();
    }
    if (obid() == 0 && tid < 256) {
        const float* lg = A_in(26); float v[4], mx = -1e30f;
#pragma unroll
        for (int l = 0; l < 4; ++l) { v[l] = lg[l * 256 + tid]; mx = fmaxf(mx, v[l]); }
        float s = 0.f;
#pragma unroll
        for (int l = 0; l < 4; ++l) { v[l] = __expf(v[l] - mx); s += v[l]; }
        float* lbs = (float*)(A_ws() + WS_LBS); float c = 0.f;
#pragma unroll
        for (int l = 0; l < 4; ++l) { if (l > 0) c += v[l] / s; lbs[l * 256 + tid] = c; }
    }
    float* tab = (float*)(lds + wave * 6144);
    float* part = (float*)(lds + 49152);
    for (int it = obid(); it < DEPTH * 96; it += gridDim.x) {
        const int l = it / 96, c0 = 64 * (it % 96);
        float acc[24];
#pragma unroll
        for (int s = 0; s < 24; ++s) acc[s] = 0.f;
        for (int rnd = 0; rnd < 2; ++rnd) {
            const int k0 = 128 * wave + 64 * rnd;
            for (int s = 0; s < 24; ++s) { const float cv = (s < NB) ? A_in(2)[s * DM + k0 + lane] : A_in(3)[(s - NB) * DM + k0 + lane]; tab[lane * 24 + s] = siluf_(cv); }
            asm volatile("s_waitcnt lgkmcnt(0)" ::: "memory");
            const float* wp = A_in(11) + ((size_t)l * DM + k0) * 6144 + c0 + lane;
#pragma unroll 16
            for (int kk = 0; kk < 64; ++kk) {
                const float wv = wp[(size_t)kk * 6144];
#pragma unroll
                for (int s4 = 0; s4 < 6; ++s4) { const f32x4 t4 = *(const f32x4*)(tab + kk * 24 + 4 * s4);
                    acc[4 * s4] += t4[0] * wv; acc[4 * s4 + 1] += t4[1] * wv; acc[4 * s4 + 2] += t4[2] * wv; acc[4 * s4 + 3] += t4[3] * wv; }
            }
            asm volatile("s_waitcnt lgkmcnt(0)" ::: "memory");
        }
#pragma unroll
        for (int s = 0; s < 24; ++s) part[(wave * 24 + s) * 64 + lane] = acc[s];
        __syncthreads();
        for (int e = tid; e < 24 * 64; e += NTHR) {
            const int s = e >> 6, cl = e & 63; float sum = A_in(12)[l * 6144 + c0 + cl];
#pragma unroll
            for (int w = 0; w < 8; ++w) sum += part[(w * 24 + s) * 64 + cl];
            ((float*)(A_ws() + WS_MOD))[((size_t)l * NSEQ + s) * 6144 + c0 + cl] = sum;
        }
        __syncthreads();
    }
}

DI void phase_norm(const float* xp, const float* xs, const float* g, const float* modl, int sh_idx, int sc_idx, bf16_t* out, int wvs__) {
    const int lane = otid() & 63, wave = otid() >> 6;
    const int gw = obid() * NWAVES + wave, NGW = gridDim.x * NWAVES;
    f32x4 g4[4];
#pragma unroll
    for (int j = 0; j < 4; ++j) g4[j] = *(const f32x4*)(g + 4 * (lane + 64 * j));
#define NRM_LD(ra_, VA, VB, SCA, SHA, SCB, SHB) do { const int rb_ = ((ra_) + NGW < MROWS) ? (ra_) + NGW : (ra_); \
        const float* xa_ = (ra_) < MP ? xp + (size_t)(ra_) * DM : xs + (size_t)((ra_) - MP) * DM; \
        const float* xb_ = rb_ < MP ? xp + (size_t)rb_ * DM : xs + (size_t)(rb_ - MP) * DM; \
        const float* ma_ = modl + (size_t)row_seq(ra_) * 6144; const float* mb_ = modl + (size_t)row_seq(rb_) * 6144; \
        _Pragma("unroll") for (int j = 0; j < 4; ++j) { const int col = 4 * (lane + 64 * j); \
            VA[j] = *(const f32x4*)(xa_ + col); VB[j] = *(const f32x4*)(xb_ + col); \
            SCA[j] = *(const f32x4*)(ma_ + sc_idx * DM + col); SHA[j] = *(const f32x4*)(ma_ + sh_idx * DM + col); \
            SCB[j] = *(const f32x4*)(mb_ + sc_idx * DM + col); SHB[j] = *(const f32x4*)(mb_ + sh_idx * DM + col); } } while (0)
    f32x4 va[4], vb[4], sca[4], sha[4], scb[4], shb[4], nva[4], nvb[4], nsca[4], nsha[4], nscb[4], nshb[4];
    int rowa = gw;
    if (rowa < MROWS) NRM_LD(rowa, va, vb, sca, sha, scb, shb);
    for (; rowa < MROWS; rowa += 2 * NGW) {
        const int rowb = rowa + NGW;
        const bool hasb = rowb < MROWS;
        if (rowa + 2 * NGW < MROWS) NRM_LD(rowa + 2 * NGW, nva, nvb, nsca, nsha, nscb, nshb);
        asm volatile("" ::: "memory");
        float sa = 0.f, sb = 0.f;
#pragma unroll
        for (int j = 0; j < 4; ++j) { sa += (va[j][0] * va[j][0] + va[j][1] * va[j][1]) + (va[j][2] * va[j][2] + va[j][3] * va[j][3]);
                                      sb += (vb[j][0] * vb[j][0] + vb[j][1] * vb[j][1]) + (vb[j][2] * vb[j][2] + vb[j][3] * vb[j][3]); }
        const float ra = rsqrtf(wave_sum_fast(sa) * (1.0f / DM) + 1e-6f), rbs = rsqrtf(wave_sum_fast(sb) * (1.0f / DM) + 1e-6f);
#pragma unroll
        for (int j = 0; j < 4; ++j) {
            const int col = 4 * (lane + 64 * j);
            const f32x4 ha = va[j] * ra * g4[j] * (sca[j] + 1.0f) + sha[j];
            *(u32x2*)(out + (size_t)rowa * DM + col) = pack4(ha);
            if (hasb) {
                const f32x4 hb = vb[j] * rbs * g4[j] * (scb[j] + 1.0f) + shb[j];
                *(u32x2*)(out + (size_t)rowb * DM + col) = pack4(hb);
            }
        }
#pragma unroll
        for (int j = 0; j < 4; ++j) { va[j] = nva[j]; vb[j] = nvb[j]; sca[j] = nsca[j]; sha[j] = nsha[j]; scb[j] = nscb[j]; shb[j] = nshb[j]; }
    }
#undef NRM_LD
}
DI void phase_final_norm(float* x, const float* g, int wvs__) {
    const int lane = otid() & 63, wave = otid() >> 6;
    const int gw = obid() * NWAVES + wave, NGW = gridDim.x * NWAVES;
    f32x4 g4[4];
#pragma unroll
    for (int j = 0; j < 4; ++j) g4[j] = *(const f32x4*)(g + 4 * (lane + 64 * j));
    for (int rowa = gw; rowa < MROWS; rowa += 2 * NGW) {
        const int rowb = rowa + NGW;
        const bool hasb = rowb < MROWS;
        float* xa = x + (size_t)rowa * DM; float* xb = x + (size_t)(hasb ? rowb : rowa) * DM;
        f32x4 va[4], vb[4]; float sa = 0.f, sb = 0.f;
#pragma unroll
        for (int j = 0; j < 4; ++j) { va[j] = *(const f32x4*)(xa + 4 * (lane + 64 * j)); vb[j] = *(const f32x4*)(xb + 4 * (lane + 64 * j)); }
        asm volatile("" ::: "memory");
#pragma unroll
        for (int j = 0; j < 4; ++j) { sa += (va[j][0] * va[j][0] + va[j][1] * va[j][1]) + (va[j][2] * va[j][2] + va[j][3] * va[j][3]);
                                      sb += (vb[j][0] * vb[j][0] + vb[j][1] * vb[j][1]) + (vb[j][2] * vb[j][2] + vb[j][3] * vb[j][3]); }
        const float ra = rsqrtf(wave_sum_fast(sa) * (1.0f / DM) + 1e-6f), rbs = rsqrtf(wave_sum_fast(sb) * (1.0f / DM) + 1e-6f);
#pragma unroll
        for (int j = 0; j < 4; ++j) { const int col = 4 * (lane + 64 * j); *(f32x4*)(xa + col) = va[j] * ra * g4[j]; if (hasb) *(f32x4*)(xb + col) = vb[j] * rbs * g4[j]; }
    }
}

DI void cumsum_item(const float* srcA, int LA, const float* srcB, int LB, float* dst, float* red  , int wvs__) {
    const int tid = otid(), lane = tid & 63, wave = tid >> 6;
    const int T = LA + LB;
    float v[8]; float run = 0.f;
#pragma unroll
    for (int j = 0; j < 8; ++j) { const int t = 8 * tid + j; float x = 0.f; if (t < LA) x = srcA[(size_t)t * 8]; else if (t < T) x = srcB[(size_t)(t - LA) * 8]; run += x; v[j] = run; }
    float inc = run;
#pragma unroll
    for (int o = 1; o < 64; o <<= 1) { const float n = __shfl_up(inc, o); if (lane >= o) inc += n; }
    if (lane == 63) red[wave] = inc;
    __syncthreads();
    float base = inc - run;
    for (int w = 0; w < wave; ++w) base += red[w];
#pragma unroll
    for (int j = 0; j < 8; ++j) { const int t = 8 * tid + j; if (t < T) dst[t] = -LOG2E * (base + v[j]); }
    __syncthreads();
}

DI void phase_prep(const Args& A, int l, unsigned char* lds, int wvs__) {
    const int tid = otid(), lane = tid & 63;
    float* outp = A_out();
    for (int it = obid(); it < 192; it += gridDim.x) {
        float* red = (float*)lds;
        if (it < 128) {
            const int b = it >> 3, h = it & 7;
            const float* src = outp + O_LFP + (size_t)l * SZ_LFP + (size_t)b * SEQ * 8 + h;
            cumsum_item(src, SEQ, src, 0, (float*)(A_ws() + WS_CB) + (size_t)it * 4096, red, wvs__);
        } else {
            const int i2 = it - 128, b = i2 >> 3, h = i2 & 7;
            const float* sa = A_in(6) + ((size_t)l * DB + b) * PAST * 8 + h;
            const float* sb = outp + O_LFS + (size_t)l * SZ_LFS + (size_t)b * DSEQ * 8 + h;
            cumsum_item(sa, PAST, sb, DSEQ, (float*)(A_ws() + WS_CBS) + (size_t)i2 * 2112, red, wvs__);
        }
    }
    const bf16_t* PRW = (const bf16_t*)(A_ws() + WS_PRW);
    const float* mu = A_in(14) + l * RWC;
    const float* shift_in = A_in(8) + (size_t)l * DB * RWC;
    bf16_t* R = (bf16_t*)(A_ws() + WS_R); bf16_t* KP = (bf16_t*)(A_ws() + WS_R + SZ_OP); bf16_t* KK = (bf16_t*)(A_ws() + WS_R + 2 * SZ_OP);
    bf16_t* KKA = (bf16_t*)(A_ws() + WS_R + 3 * SZ_OP); bf16_t* V = (bf16_t*)(A_ws() + WS_R + 4 * SZ_OP); bf16_t* G = (bf16_t*)(A_ws() + WS_R + 5 * SZ_OP);
    float* W = (float*)(A_ws() + WS_W); float* BON = (float*)(A_ws() + WS_BON);
    unsigned* inb2 = (unsigned*)(lds + 1024);
    const int col = tid & 255, th = tid >> 8, tk0 = 8 * th;
    unsigned* wl = (unsigned*)(lds + 16384);
    __syncthreads();
    {
        const float* w2 = A_in(16) + (size_t)l * 32 * 256; const float* a2 = A_in(18) + (size_t)l * 32 * 256; const float* g2 = A_in(19) + (size_t)l * 64 * 256;
        for (int e = tid; e < 64 * 256; e += NTHR) {
            const int i2 = e >> 8, c = e & 255;
            const float* src = i2 < 16 ? w2 + (2 * i2) * 256 + c : (i2 < 32 ? a2 + (2 * (i2 - 16)) * 256 + c : g2 + (2 * (i2 - 32)) * 256 + c);
            wl[e] = pk2(src[0], src[256]);
        }
    }
    const float mur = mu[col], muk = mu[256 + col], muv = mu[512 + col];
    const float w0c = A_in(15)[l * 256 + col], a0c = A_in(17)[l * 256 + col], kkc = A_in(20)[l * 256 + col], kac = A_in(21)[l * 256 + col], rkc = A_in(22)[l * 256 + col];
    for (int grp = obid(); grp < MROWS / 16; grp += gridDim.x) {
        __syncthreads();
        for (int e = tid; e < 64 * 16; e += NTHR) {
            const int tk = e & 15, i2 = e >> 4, row = grp * 16 + tk, c = 768 + 2 * i2;
            const unsigned pw_ = *(const unsigned*)(PRW + (size_t)row * RWC + c);
            const int pos = row < MP ? (row & 4095) : ((row - MP) & 31);
            float pv0, pv1;
            if (pos > 0) { const unsigned q_ = *(const unsigned*)(PRW + (size_t)(row - 1) * RWC + c); pv0 = bflo(q_); pv1 = bfhi(q_); }
            else if (row < MP) { pv0 = 0.f; pv1 = 0.f; }
            else { const float* sp = shift_in + (size_t)((row - MP) >> 5) * RWC + c; pv0 = sp[0]; pv1 = sp[1]; }
            const float p0 = bflo(pw_), p1 = bfhi(pw_);
            const float x0 = p0 + mu[c] * (pv0 - p0), x1 = p1 + mu[c + 1] * (pv1 - p1);
            float v0, v1;
            if (i2 < 16) { v0 = 1.0f - 2.0f * __builtin_amdgcn_rcpf(1.0f + __expf(2.0f * x0)); v1 = 1.0f - 2.0f * __builtin_amdgcn_rcpf(1.0f + __expf(2.0f * x1)); }
            else if (i2 < 32) { v0 = x0; v1 = x1; }
            else { v0 = sigmoidf_(x0); v1 = sigmoidf_(x1); }
            inb2[i2 * 16 + tk] = pk2(v0, v1);
        }
        __syncthreads();
        const int row0 = grp * 16 + tk0;
        const int pos0 = row0 < MP ? (row0 & 4095) : ((row0 - MP) & 31);
        float pv_r = 0.f, pv_k = 0.f, pv_v = 0.f;
        if (pos0 > 0) { const bf16_t* pp = PRW + (size_t)(row0 - 1) * RWC; pv_r = bf2f(pp[col]); pv_k = bf2f(pp[256 + col]); pv_v = bf2f(pp[512 + col]); }
        else if (row0 >= MP) { const float* sp = shift_in + (size_t)((row0 - MP) >> 5) * RWC; pv_r = sp[col]; pv_k = sp[256 + col]; pv_v = sp[512 + col]; }
        unsigned short qr_[8], qk_[8], qv_[8];
#pragma unroll
        for (int t = 0; t < 8; ++t) { const bf16_t* pr = PRW + (size_t)(row0 + t) * RWC; qr_[t] = pr[col]; qk_[t] = pr[256 + col]; qv_[t] = pr[512 + col]; }
        asm volatile("" ::: "memory");
        float lw[8], la[8], lg[8];
#pragma unroll
        for (int t = 0; t < 8; ++t) { lw[t] = 0.f; la[t] = 0.f; lg[t] = 0.f; }
#define DOT2(x_, w_, acc_) __builtin_amdgcn_fdot2_f32_bf16(__builtin_bit_cast(bf16x2_t, (unsigned)(x_)), __builtin_bit_cast(bf16x2_t, (unsigned)(w_)), (acc_), false)
#pragma unroll 4
        for (int i2 = 0; i2 < 16; ++i2) {
            const unsigned wp = wl[i2 * 256 + col], ap = wl[(16 + i2) * 256 + col];
            const u32x4 x0 = *(const u32x4*)(inb2 + i2 * 16 + tk0), x1 = *(const u32x4*)(inb2 + i2 * 16 + tk0 + 4);
            const u32x4 y0 = *(const u32x4*)(inb2 + (16 + i2) * 16 + tk0), y1 = *(const u32x4*)(inb2 + (16 + i2) * 16 + tk0 + 4);
#pragma unroll
            for (int t = 0; t < 4; ++t) { lw[t] = DOT2(x0[t], wp, lw[t]); lw[4 + t] = DOT2(x1[t], wp, lw[4 + t]); la[t] = DOT2(y0[t], ap, la[t]); la[4 + t] = DOT2(y1[t], ap, la[4 + t]); }
        }
#pragma unroll 4
        for (int i2 = 0; i2 < 32; ++i2) {
            const unsigned gp = wl[(32 + i2) * 256 + col];
            const u32x4 x0 = *(const u32x4*)(inb2 + (32 + i2) * 16 + tk0), x1 = *(const u32x4*)(inb2 + (32 + i2) * 16 + tk0 + 4);
#pragma unroll
            for (int t = 0; t < 4; ++t) { lg[t] = DOT2(x0[t], gp, lg[t]); lg[4 + t] = DOT2(x1[t], gp, lg[4 + t]); }
        }
#undef DOT2
#pragma unroll
        for (int t = 0; t < 8; ++t) {
            const int row = row0 + t;
            const float pr_r = bf2f(qr_[t]), pr_k = bf2f(qk_[t]), pr_v = bf2f(qv_[t]);
            const float xr = pr_r + mur * (pv_r - pr_r), xk = pr_k + muk * (pv_k - pr_k), xv = pr_v + muv * (pv_v - pr_v);
            pv_r = pr_r; pv_k = pr_k; pv_v = pr_v;
            const float e = 0.6065306597126334f * sigmoidf_(w0c + lw[t]);
            const float wdec = __expf(-e);
            const float a = sigmoidf_(a0c + la[t]);
            const float kkr = xk * kkc;
            const float ss = wave_sum_fast(kkr * kkr);
            const float kk = kkr * rsqrtf(fmaxf(ss, 1e-24f));
            const float kp = xk * (1.0f + (a - 1.0f) * kac);
            const float bon = wave_sum_fast(xr * kp * rkc);
            const size_t o = (size_t)row * 256 + col;
            const unsigned q0 = pk2(xr, kp), q1 = pk2(kk, kk * a), q2 = pk2(xv, lg[t]);
            R[o] = (bf16_t)(q0 & 0xffffu); KP[o] = (bf16_t)(q0 >> 16); KK[o] = (bf16_t)(q1 & 0xffffu);
            KKA[o] = (bf16_t)(q1 >> 16); V[o] = (bf16_t)(q2 & 0xffffu); G[o] = (bf16_t)(q2 >> 16);
            W[o] = wdec;
            if (lane == 0) BON[(size_t)row * 4 + (col >> 6)] = bon;
        }
    }
}


constexpr int SC_TOK0 = 336, SC_TOK1 = 208;
constexpr int SC_OP1 = 2 * 16 * SC_TOK0 * 4;
constexpr int SC_YP = SC_OP1 + 2 * 16 * SC_TOK1 * 4;
static_assert(SC_YP + 4 * 16384 <= LDS_BYTES, "scan LDS map");

DI void scan_items(const Args& A, int l, unsigned char* lds, int seq, int head, int vq, int wvs__) {
    const int tid = otid(), hw = tid >> 8, t256 = tid & 255, lane = tid & 63, wv = (tid >> 6) & 3;
    const int rowl = wv * 4 + (lane >> 4), kg = lane & 15;
    const int T = seq < NB ? SEQ : DSEQ;
    const int rowbase = seq < NB ? seq * SEQ : MP + (seq - NB) * DSEQ;
    const int nch = T / 16;
    const int sctok = hw == 0 ? SC_TOK0 : SC_TOK1;
    float* opb = (float*)(lds + hw * SC_OP1);
    float* ypb = (float*)(lds + SC_YP + hw * 32768);
    const int tok = t256 >> 4, part = t256 & 15;
    const int colh = head * 64 + 4 * part, colv = head * 64 + vq * 16 + 4 * part;
    const bf16_t* R = (const bf16_t*)(A_ws() + WS_R); const bf16_t* KP = (const bf16_t*)(A_ws() + WS_R + SZ_OP); const bf16_t* KK = (const bf16_t*)(A_ws() + WS_R + 2 * SZ_OP);
    const bf16_t* KKA = (const bf16_t*)(A_ws() + WS_R + 3 * SZ_OP); const bf16_t* V = (const bf16_t*)(A_ws() + WS_R + 4 * SZ_OP);
    const float* W = (const float*)(A_ws() + WS_W);
    const bf16_t* PHG = (const bf16_t*)(A_ws() + WS_PHG);
    float* YD = hw == 0 ? (float*)(A_ws() + WS_PRW) : (float*)(A_ws() + WS_OHG);
    f32x4 lb4 = {0.f, 0.f, 0.f, 0.f};
    if (hw == 1) lb4 = *(const f32x4*)((const float*)(A_ws() + WS_LBS) + l * 256 + colh);
    f32x2 Sa = {0.f, 0.f}, Sb = {0.f, 0.f};
    const int vrow = vq * 16 + rowl;
    if (seq >= NB) {
        const int b = seq - NB;
        if (hw == 0) { const f32x4 s4 = *(const f32x4*)(A_in(7) + ((((size_t)l * DB + b) * 4 + head) * 64 + vrow) * 64 + 4 * kg); Sa = (f32x2){s4[0], s4[1]}; Sb = (f32x2){s4[2], s4[3]}; }
        else { const float* sp = A_in(9) + (((size_t)l * DB + b) * 4 + head) * 4096 + vrow; Sa = (f32x2){sp[(4 * kg) * 64], sp[(4 * kg + 1) * 64]}; Sb = (f32x2){sp[(4 * kg + 2) * 64], sp[(4 * kg + 3) * 64]}; }
    }
    u32x2 pa, pb, pc, pd, pe; f32x4 pw;
    pa = pb = pc = pd = pe = (u32x2){0u, 0u}; pw = (f32x4){0.f, 0.f, 0.f, 0.f};
#define SC_LOAD(c) do { const size_t row_ = (size_t)(rowbase + (c) * 16 + tok); \
        if (hw == 0) { pa = *(const u32x2*)(R + row_ * 256 + colh); pb = *(const u32x2*)(KP + row_ * 256 + colh); pc = *(const u32x2*)(KK + row_ * 256 + colh); \
                       pd = *(const u32x2*)(KKA + row_ * 256 + colh); pw = *(const f32x4*)(W + row_ * 256 + colh); if (part < 4) pe = *(const u32x2*)(V + row_ * 256 + colv); } \
        else { pa = *(const u32x2*)(PHG + row_ * 1024 + colh); pb = *(const u32x2*)(PHG + row_ * 1024 + 256 + colh); if (part < 4) pe = *(const u32x2*)(PHG + row_ * 1024 + 512 + colv); } } while (0)
#define SC_STORE(bufi) do { float* d_ = opb + ((bufi) * 16 + tok) * sctok; \
        if (hw == 0) { *(f32x4*)(d_ + 4 * part) = unpack4(pa); *(f32x4*)(d_ + 64 + 4 * part) = pw; *(f32x4*)(d_ + 128 + 4 * part) = unpack4(pb); \
                       *(f32x4*)(d_ + 192 + 4 * part) = unpack4(pc); *(f32x4*)(d_ + 256 + 4 * part) = unpack4(pd); if (part < 4) *(f32x4*)(d_ + 320 + 4 * part) = unpack4(pe); } \
        else { const f32x4 fx_ = unpack4(pb); f32x4 f_, k_; \
               _Pragma("unroll") for (int j_ = 0; j_ < 4; ++j_) { const float sg_ = sigmoidf_(fx_[j_]); f_[j_] = lb4[j_] + (1.0f - lb4[j_]) * sg_; k_[j_] = (1.0f - lb4[j_]) * (1.0f - sg_); } \
               *(f32x4*)(d_ + 4 * part) = unpack4(pa); *(f32x4*)(d_ + 64 + 4 * part) = f_; *(f32x4*)(d_ + 128 + 4 * part) = k_; if (part < 4) *(f32x4*)(d_ + 192 + 4 * part) = unpack4(pe); } } while (0)
    __syncthreads();
    SC_LOAD(0); SC_STORE(0);
    __syncthreads();
    for (int c = 0; c < nch; ++c) {
        const bool more = (c + 1 < nch);
        if (more) SC_LOAD(c + 1);
        float* yp = ypb + (c & 1) * 4096 + rowl * 16 + kg;
        if (hw == 0) {
            const float* buf = opb + (c & 1) * 16 * SC_TOK0 + 4 * kg;
            const float* vb = opb + (c & 1) * 16 * SC_TOK0 + 320 + rowl;
#define RW_LD(s_, X) do { const float* tb_ = buf + (s_) * SC_TOK0; X##r = *(const f32x4*)tb_; X##w = *(const f32x4*)(tb_ + 64); X##p = *(const f32x4*)(tb_ + 128); \
                          X##k = *(const f32x4*)(tb_ + 192); X##a = *(const f32x4*)(tb_ + 256); X##v = vb[(s_) * SC_TOK0]; } while (0)
#define RW_STEP(s_, X) do { const f32x2 vv2_ = {X##v, X##v}; \
                const f32x2 pva_ = (f32x2){X##p[0], X##p[1]} * vv2_, pvb_ = (f32x2){X##p[2], X##p[3]} * vv2_; \
                f32x2 t_ = Sa * (f32x2){X##k[0], X##k[1]}; t_ = Sb * (f32x2){X##k[2], X##k[3]} + t_; \
                const float skk_ = row16_sum(t_[0] + t_[1]); const f32x2 sk2_ = {skk_, skk_}; \
                Sa = Sa * (f32x2){X##w[0], X##w[1]} + (pva_ - (f32x2){X##a[0], X##a[1]} * sk2_); \
                Sb = Sb * (f32x2){X##w[2], X##w[3]} + (pvb_ - (f32x2){X##a[2], X##a[3]} * sk2_); \
                f32x2 yy_ = Sa * (f32x2){X##r[0], X##r[1]}; yy_ = Sb * (f32x2){X##r[2], X##r[3]} + yy_; \
                yp[(s_) * 256] = yy_[0] + yy_[1]; } while (0)
            f32x4 Ar, Aw, Ap, Ak, Aa, Br, Bw, Bp, Bk, Ba; float Av, Bv;
            RW_LD(0, A);
#pragma unroll
            for (int s = 0; s < 16; s += 2) {
                RW_LD(s + 1, B);
                RW_STEP(s, A);
                if (s + 2 < 16) RW_LD(s + 2, A);
                RW_STEP(s + 1, B);
            }
#undef RW_LD
#undef RW_STEP
        } else {
            const float* buf = opb + (c & 1) * 16 * SC_TOK1 + 4 * kg;
            const float* vb = opb + (c & 1) * 16 * SC_TOK1 + 192 + rowl;
#define HG_LD(s_, X) do { const float* tb_ = buf + (s_) * SC_TOK1; X##q = *(const f32x4*)tb_; X##f = *(const f32x4*)(tb_ + 64); X##k = *(const f32x4*)(tb_ + 128); X##v = vb[(s_) * SC_TOK1]; } while (0)
#define HG_STEP(s_, X) do { const f32x2 iv2_ = {X##v, X##v}; \
                Sa = Sa * (f32x2){X##f[0], X##f[1]} + (f32x2){X##k[0], X##k[1]} * iv2_; \
                Sb = Sb * (f32x2){X##f[2], X##f[3]} + (f32x2){X##k[2], X##k[3]} * iv2_; \
                f32x2 yy_ = Sa * (f32x2){X##q[0], X##q[1]}; yy_ = Sb * (f32x2){X##q[2], X##q[3]} + yy_; \
                yp[(s_) * 256] = yy_[0] + yy_[1]; } while (0)
            f32x4 Aq, Af, Ak, Bq, Bf, Bk; float Av, Bv;
            HG_LD(0, A);
#pragma unroll
            for (int s = 0; s < 16; s += 2) {
                HG_LD(s + 1, B);
                HG_STEP(s, A);
                if (s + 2 < 16) HG_LD(s + 2, A);
                HG_STEP(s + 1, B);
            }
#undef HG_LD
#undef HG_STEP
        }
        if (more) SC_STORE((c + 1) & 1);
        __syncthreads();
        {
            const float* q = ypb + (c & 1) * 4096 + tok * 256 + part * 16;
            const f32x4 a0 = *(const f32x4*)q, a1 = *(const f32x4*)(q + 4), a2 = *(const f32x4*)(q + 8), a3 = *(const f32x4*)(q + 12);
            const f32x4 sm = (a0 + a1) + (a2 + a3);
            YD[(size_t)(rowbase + c * 16 + tok) * 256 + head * 64 + vq * 16 + part] = (sm[0] + sm[1]) + (sm[2] + sm[3]);
        }
    }
#undef SC_LOAD
#undef SC_STORE
    if (hw == 0) {
        float* d = (seq < NB ? A_out() + O_RSP + (size_t)l * SZ_RSP + (((size_t)seq * 4 + head) * 64 + vrow) * 64
                             : A_out() + O_RSS + (size_t)l * SZ_RSS + (((size_t)(seq - NB) * 4 + head) * 64 + vrow) * 64) + 4 * kg;
        *(f32x4*)d = (f32x4){Sa[0], Sa[1], Sb[0], Sb[1]};
    } else {
        float* d = (seq < NB ? A_out() + O_HSP + (size_t)l * SZ_RSP + ((size_t)seq * 4 + head) * 4096
                             : A_out() + O_HSS + (size_t)l * SZ_RSS + ((size_t)(seq - NB) * 4 + head) * 4096) + vrow;
        d[(4 * kg) * 64] = Sa[0]; d[(4 * kg + 1) * 64] = Sa[1]; d[(4 * kg + 2) * 64] = Sb[0]; d[(4 * kg + 3) * 64] = Sb[1];
    }
}

#define MFMA32(a, b, c) __builtin_amdgcn_mfma_f32_32x32x16_bf16((a), (b), (c), 0, 0, 0)
typedef short v4i16_t __attribute__((ext_vector_type(4)));
DI int crow(int i, int h) { return (i & 3) + 8 * (i >> 2) + 4 * h; }
DI void attn_unit(unsigned char* lds, const bf16_t* Q, int nq, const float* KA, const float* VA, int LA, const float* KB, const float* VB, int LB,
                  const float* cb, int qoff, float kmax, bf16_t* O, int wvs__) {
    const int tid = otid(), lane = tid & 63, wid = tid >> 6, r = lane & 31, h = lane >> 5;
    const int Ltot = LA + LB, NT = (Ltot + 63) >> 6;
    const bool active = (32 * wid < nq);
    const int qmin = qoff + 32 * wid;
    bf16x8 qf[4];
    float qn2 = 0.f;
#pragma unroll
    for (int ks = 0; ks < 4; ++ks) {
        qf[ks] = (bf16x8){0, 0, 0, 0, 0, 0, 0, 0};
        if (active) qf[ks] = *(const bf16x8*)(Q + (size_t)(32 * wid + r) * 512 + 16 * ks + 8 * h);
#pragma unroll
        for (int j = 0; j < 8; ++j) { const float qv = bf2f((unsigned short)qf[ks][j]); qn2 += qv * qv; }
    }
    qn2 += __shfl_xor(qn2, 32);
    const float cbq = cb[active ? qmin + r : qoff];
    const float mf = cbq + sqrtf(qn2) * kmax * 1.02f + 1.0f;
    int t0;
    {
        volatile int* slot2 = (volatile int*)(lds + 36880);
        __syncthreads();
        if (wid == 0) {
            int ke = 64 * lane + 63; ke = ke < Ltot - 1 ? ke : Ltot - 1;
            const bool ok = (lane < NT) && (cb[ke] - cb[qoff] >= -126.0f);
            const unsigned long long bal = __ballot(ok);
            if (lane == 0) *slot2 = bal ? (int)__builtin_ctzll(bal) : NT - 1;
        }
        __syncthreads();
        t0 = *slot2;
    }
    f32x16 o0, o1;
#pragma unroll
    for (int i = 0; i < 16; ++i) { o0[i] = 0.f; o1[i] = 0.f; }
    float lsum = 0.f;
    const int krow_l = tid & 63, kch = tid >> 6;
    const int vrow_l = (wid & 3) * 16 + (lane >> 2), vcol = (wid >> 2) * 32 + (lane & 3) * 8;
    f32x4 k0, k1, v0, v1; float bv = 0.f;
#define AT_LOAD(t) do { int kr_ = 64 * (t) + krow_l; kr_ = kr_ < Ltot ? kr_ : Ltot - 1; \
        const float* s_ = (kr_ < LA ? KA + (size_t)kr_ * 512 : KB + (size_t)(kr_ - LA) * 512) + kch * 8; k0 = *(const f32x4*)s_; k1 = *(const f32x4*)(s_ + 4); \
        int vr_ = 64 * (t) + vrow_l; vr_ = vr_ < Ltot ? vr_ : Ltot - 1; \
        const float* sv_ = (vr_ < LA ? VA + (size_t)vr_ * 512 : VB + (size_t)(vr_ - LA) * 512) + vcol; v0 = *(const f32x4*)sv_; v1 = *(const f32x4*)(sv_ + 4); \
        if (tid < 64) { const int kb_ = 64 * (t) + tid; bv = kb_ < Ltot ? cb[kb_] : 0.f; } } while (0)
#define AT_STORE(b) do { *(u32x4*)(lds + (b) * 8192 + tid * 16) = pack8(k0, k1); *(u32x4*)(lds + 16384 + (b) * 8192 + tid * 16) = pack8(v0, v1); \
        if (tid < 64) *(float*)(lds + 32768 + (b) * 256 + tid * 4) = bv; } while (0)
    AT_LOAD(t0); AT_STORE(t0 & 1);
    __syncthreads();
    const int tq = (lane & 15) >> 2, tp = lane & 3, tblk = (lane >> 4) & 1;
    for (int t = t0; t < NT; ++t) {
        const int b = t & 1;
        const bool more = (t + 1 < NT);
        if (more) AT_LOAD(t + 1);
        if (active && 64 * t <= qmin + 31) {
            const unsigned char* Kimg = lds + b * 8192;
            const float* Bimg = (const float*)(lds + 32768 + b * 256);
            f32x16 st0, st1;
#pragma unroll
            for (int g = 0; g < 4; ++g) {
                const f32x4 b0 = *(const f32x4*)(Bimg + 8 * g + 4 * h), b1 = *(const f32x4*)(Bimg + 32 + 8 * g + 4 * h);
#pragma unroll
                for (int j = 0; j < 4; ++j) { st0[4 * g + j] = b0[j] - mf; st1[4 * g + j] = b1[j] - mf; }
            }
            bf16x8 kfa[4], kfb[4];
#pragma unroll
            for (int ks = 0; ks < 4; ++ks) { kfa[ks] = *(const bf16x8*)(Kimg + (2 * ks + h) * 1024 + r * 16); kfb[ks] = *(const bf16x8*)(Kimg + (2 * ks + h) * 1024 + r * 16 + 512); }
            __builtin_amdgcn_s_setprio(1);
#pragma unroll
            for (int ks = 0; ks < 4; ++ks) { st0 = MFMA32(kfa[ks], qf[ks], st0); st1 = MFMA32(kfb[ks], qf[ks], st1); }
            __builtin_amdgcn_s_setprio(0);
            if (64 * t + 63 > qmin || 64 * t + 63 >= Ltot) {
                int lim = qmin + r; lim = lim < Ltot - 1 ? lim : Ltot - 1;
#pragma unroll
                for (int i = 0; i < 16; ++i) { const int kv = 64 * t + crow(i, h); if (kv > lim) st0[i] = -INFINITY; if (kv + 32 > lim) st1[i] = -INFINITY; }
            }
            float ls = 0.f;
#pragma unroll
            for (int i = 0; i < 16; ++i) { st0[i] = __builtin_amdgcn_exp2f(st0[i]); st1[i] = __builtin_amdgcn_exp2f(st1[i]); ls += st0[i] + st1[i]; }
            lsum += ls;
            bf16x8 pf[4];
            { u32x4 w;
              w.x = pk2(st0[0], st0[1]); w.y = pk2(st0[2], st0[3]); w.z = pk2(st0[4], st0[5]); w.w = pk2(st0[6], st0[7]); pf[0] = __builtin_bit_cast(bf16x8, w);
              w.x = pk2(st0[8], st0[9]); w.y = pk2(st0[10], st0[11]); w.z = pk2(st0[12], st0[13]); w.w = pk2(st0[14], st0[15]); pf[1] = __builtin_bit_cast(bf16x8, w);
              w.x = pk2(st1[0], st1[1]); w.y = pk2(st1[2], st1[3]); w.z = pk2(st1[4], st1[5]); w.w = pk2(st1[6], st1[7]); pf[2] = __builtin_bit_cast(bf16x8, w);
              w.x = pk2(st1[8], st1[9]); w.y = pk2(st1[10], st1[11]); w.z = pk2(st1[12], st1[13]); w.w = pk2(st1[14], st1[15]); pf[3] = __builtin_bit_cast(bf16x8, w); }
            LAS unsigned char* Vimg = (LAS unsigned char*)lds + 16384 + b * 8192 + (4 * h + tq) * 64 + tblk * 32 + tp * 8;
#pragma unroll
            for (int ks = 0; ks < 4; ++ks) {
                const v4i16_t lo0 = __builtin_amdgcn_ds_read_tr16_b64_v4i16((LAS v4i16_t*)(Vimg + ks * 1024));
                const v4i16_t hi0 = __builtin_amdgcn_ds_read_tr16_b64_v4i16((LAS v4i16_t*)(Vimg + ks * 1024 + 512));
                const v4i16_t lo1 = __builtin_amdgcn_ds_read_tr16_b64_v4i16((LAS v4i16_t*)(Vimg + 4096 + ks * 1024));
                const v4i16_t hi1 = __builtin_amdgcn_ds_read_tr16_b64_v4i16((LAS v4i16_t*)(Vimg + 4096 + ks * 1024 + 512));
                const bf16x8 vf0 = (bf16x8){lo0[0], lo0[1], lo0[2], lo0[3], hi0[0], hi0[1], hi0[2], hi0[3]};
                const bf16x8 vf1 = (bf16x8){lo1[0], lo1[1], lo1[2], lo1[3], hi1[0], hi1[1], hi1[2], hi1[3]};
                __builtin_amdgcn_s_setprio(1); o0 = MFMA32(vf0, pf[ks], o0); o1 = MFMA32(vf1, pf[ks], o1); __builtin_amdgcn_s_setprio(0);
            }
        }
        if (more) AT_STORE(b ^ 1);
        __syncthreads();
    }
#undef AT_LOAD
#undef AT_STORE
    if (active) {
        lsum += __shfl_xor(lsum, 32);
        const float inv = 1.0f / lsum;
        bf16_t* orow = O + (size_t)(32 * wid + r) * DM;
#pragma unroll
        for (int g = 0; g < 4; ++g) {
            const f32x4 a = (f32x4){o0[4 * g], o0[4 * g + 1], o0[4 * g + 2], o0[4 * g + 3]} * inv;
            const f32x4 c = (f32x4){o1[4 * g], o1[4 * g + 1], o1[4 * g + 2], o1[4 * g + 3]} * inv;
            *(u32x2*)(orow + 8 * g + 4 * h) = pack4(a);
            *(u32x2*)(orow + 32 + 8 * g + 4 * h) = pack4(c);
        }
    }
}

DI void phase_mix(const Args& A, int l, unsigned char* lds, int wvs__) {
    for (int it = obid(); it < 384; it += gridDim.x) {
        int seq, head, vq;
        if (it < 256) { seq = it >> 4; head = (it >> 2) & 3; vq = it & 3; }
        else { const int i2 = it - 256; seq = NB + (i2 >> 4); head = (i2 >> 2) & 3; vq = i2 & 3; }
        scan_items(A, l, lds, seq, head, vq, wvs__);
        __syncthreads();
    }
    const bf16_t* Qb = (const bf16_t*)(A_ws() + WS_Q);
    bf16_t* HB = (bf16_t*)(A_ws() + WS_HB);
    const float* KNE = (const float*)(A_ws() + WS_KNE) + (size_t)l * NSEQ * 16;
    const float* KNC = (const float*)(A_ws() + WS_KNC) + l * 64;
    unsigned* cnt = (unsigned*)(A_ws() + WS_CNT) + l;
    volatile unsigned* slot = (volatile unsigned*)(lds + 36864);
    unsigned nxt = 0u;
    if (otid() == 0) nxt = __hip_atomic_fetch_add(cnt, 1u, __ATOMIC_RELAXED, __HIP_MEMORY_SCOPE_AGENT);
    for (;;) {
        __syncthreads();
        if (otid() == 0) *slot = nxt;
        __syncthreads();
        const int idx = (int)*slot;
        if (idx >= 64 + 2048) break;
        if (otid() == 0) nxt = __hip_atomic_fetch_add(cnt, 1u, __ATOMIC_RELAXED, __HIP_MEMORY_SCOPE_AGENT);
        if (idx < 64) {
            const int b = idx >> 3, h = idx & 7;
            const float* Ka = A_in(4) + ((size_t)l * DB + b) * PAST * 512 + h * 64;
            const float* Va = A_in(5) + ((size_t)l * DB + b) * PAST * 512 + h * 64;
            const float* Kn = A_out() + O_KS + (size_t)l * SZ_KS + (size_t)b * DSEQ * 512 + h * 64;
            const float* Vn = A_out() + O_VS + (size_t)l * SZ_KS + (size_t)b * DSEQ * 512 + h * 64;
            const float* cb = (const float*)(A_ws() + WS_CBS) + (size_t)idx * 2112;
            const size_t row0 = (size_t)MP + b * DSEQ;
            attn_unit(lds, Qb + row0 * 512 + h * 64, 32, Ka, Va, PAST, Kn, Vn, DSEQ, cb, PAST, sqrtf(fmaxf(KNC[idx], KNE[((NB + b) * 8 + h) * 2] + KNE[((NB + b) * 8 + h) * 2 + 1])), HB + row0 * DM + 256 + h * 64, wvs__);
        } else {
            const int i = idx - 64, qb = 15 - (i >> 7), bh = i & 127, b = bh >> 3, h = bh & 7;
            const float* Kb = A_out() + O_KP + (size_t)l * SZ_KP + (size_t)b * SEQ * 512 + h * 64;
            const float* Vb = A_out() + O_VP + (size_t)l * SZ_KP + (size_t)b * SEQ * 512 + h * 64;
            const float* cb = (const float*)(A_ws() + WS_CB) + (size_t)bh * 4096;
            const size_t row0 = (size_t)b * SEQ + 256 * qb;
            attn_unit(lds, Qb + row0 * 512 + h * 64, 256, Kb, Vb, 256 * qb + 256, Kb, Vb, 0, cb, 256 * qb, sqrtf(KNE[(b * 8 + h) * 2] + KNE[(b * 8 + h) * 2 + 1]), HB + row0 * DM + 256 + h * 64, wvs__);
        }
    }
}

DI void phase_post(const Args& A, int l, int wvs__) {
    const int tid = otid(), col = tid & 255, th = tid >> 8;
    const float* YRW = (const float*)(A_ws() + WS_PRW); const float* OHG = (const float*)(A_ws() + WS_OHG);
    const bf16_t* V = (const bf16_t*)(A_ws() + WS_R + 4 * SZ_OP); const bf16_t* G = (const bf16_t*)(A_ws() + WS_R + 5 * SZ_OP);
    const float* BON = (const float*)(A_ws() + WS_BON); const bf16_t* PHG = (const bf16_t*)(A_ws() + WS_PHG);
    bf16_t* HB = (bf16_t*)(A_ws() + WS_HB);
    const float lnw = A_in(23)[l * 256 + col], lnb = A_in(24)[l * 256 + col], ng = A_in(27)[l * 256 + col];
#define POST_LD(r0_, Y, OG, BN, VV, GT, GG) do { _Pragma("unroll") for (int k = 0; k < 4; ++k) { const size_t o_ = (size_t)((r0_) + k) * 256 + col; \
        Y[k] = YRW[o_]; OG[k] = OHG[o_]; BN[k] = BON[(size_t)((r0_) + k) * 4 + (col >> 6)]; VV[k] = V[o_]; GT[k] = G[o_]; GG[k] = PHG[(size_t)((r0_) + k) * 1024 + 768 + col]; } } while (0)
    float y[4], og[4], bon[4], yn_[4], ogn_[4], bonn_[4]; bf16_t vv[4], gt[4], gg[4], vvn_[4], gtn_[4], ggn_[4];
    const int stride = 8 * gridDim.x;
    int row0 = (obid() * 2 + th) * 4;
    if (row0 < MROWS) POST_LD(row0, y, og, bon, vv, gt, gg);
    for (; row0 < MROWS; row0 += stride) {
        const bool more = row0 + stride < MROWS;
        if (more) POST_LD(row0 + stride, yn_, ogn_, bonn_, vvn_, gtn_, ggn_);
        asm volatile("" ::: "memory");
        float mean[4], ms[4], var[4];
#pragma unroll
        for (int k = 0; k < 4; ++k) { mean[k] = wave_sum_fast(y[k]) * (1.0f / 64.0f); ms[k] = wave_sum_fast(og[k] * og[k]) * (1.0f / 64.0f); }
#pragma unroll
        for (int k = 0; k < 4; ++k) { const float d = y[k] - mean[k]; var[k] = wave_sum_fast(d * d) * (1.0f / 64.0f); }
#pragma unroll
        for (int k = 0; k < 4; ++k) {
            const float yn = (y[k] - mean[k]) * rsqrtf(var[k] + 64e-5f) * lnw + lnb;
            const float res = (yn + bon[k] * bf2f(vv[k])) * bf2f(gt[k]);
            const float r2 = og[k] * rsqrtf(ms[k] + 1e-6f) * ng * siluf_(bf2f(gg[k]));
            HB[(size_t)(row0 + k) * DM + col] = (bf16_t)(pk2(res, 0.f) & 0xffffu);
            HB[(size_t)(row0 + k) * DM + 768 + col] = (bf16_t)(pk2(r2, 0.f) & 0xffffu);
        }
#pragma unroll
        for (int k = 0; k < 4; ++k) { y[k] = yn_[k]; og[k] = ogn_[k]; bon[k] = bonn_[k]; vv[k] = vvn_[k]; gt[k] = gtn_[k]; gg[k] = ggn_[k]; }
    }
#undef POST_LD
}

DI f32x16 small_tile(const bf16_t* ap, const bf16_t* bp, int ks0, int nks) {
    f32x16 acc;
#pragma unroll
    for (int i = 0; i < 16; ++i) acc[i] = 0.f;
#pragma unroll 8
    for (int ks = ks0; ks < ks0 + nks; ++ks) {
        const bf16x8 a = *(const bf16x8*)(ap + 16 * ks), b = *(const bf16x8*)(bp + 16 * ks);
        acc = MFMA32(a, b, acc);
    }
    return acc;
}
DI void small_res(unsigned char* lds, const bf16_t* Asamp, int K, const bf16_t* Wt, const float* xin_s, float* xout_s, const float* ga, int wvs__) {
    const int lane = otid() & 63, r = lane & 31, h = lane >> 5, w = wvs__;
    float* part = (float*)lds;
    const int nks = K / 128;
    for (int task = obid(); task < 256; task += gridDim.x) {
        const int rb = task >> 5, cbk = task & 31;
        const f32x16 acc = small_tile(Asamp + (size_t)(32 * rb + r) * K + 8 * h, Wt + (size_t)(32 * cbk + r) * K + 8 * h, w * nks, nks);
        __syncthreads();
#pragma unroll
        for (int i = 0; i < 16; ++i) part[(w * 16 + i) * 64 + lane] = acc[i];
        __syncthreads();
        const int col = 32 * cbk + r;
        const float g = ga[(size_t)(NB + rb) * 6144 + col];
#pragma unroll
        for (int ii = 0; ii < 2; ++ii) {
            const int i = 2 * w + ii; float sum = 0.f;
#pragma unroll
            for (int ww = 0; ww < 8; ++ww) sum += part[(ww * 16 + i) * 64 + lane];
            const size_t o = (size_t)(32 * rb + crow(i, h)) * DM + col; xout_s[o] = xin_s[o] + g * sum;
        }
    }
}
DI void small_swiglu(unsigned char* lds, const bf16_t* Asamp, const bf16_t* Wt, bf16_t* mid_s, int wvs__) {
    const int lane = otid() & 63, r = lane & 31, h = lane >> 5, w = wvs__;
    float* part = (float*)lds;
    for (int task = obid(); task < 704; task += gridDim.x) {
        const int rb = task / 88, jb = task % 88, j0 = 32 * jb, T = j0 >> 7, c = j0 & 127;
        const bf16_t* ap = Asamp + (size_t)(32 * rb + r) * DM + 8 * h;
        const f32x16 ag = small_tile(ap, Wt + (size_t)(256 * T + c + r) * DM + 8 * h, w * 8, 8);
        const f32x16 au = small_tile(ap, Wt + (size_t)(256 * T + 128 + c + r) * DM + 8 * h, w * 8, 8);
        __syncthreads();
#pragma unroll
        for (int i = 0; i < 16; ++i) { part[(w * 16 + i) * 64 + lane] = ag[i]; part[8192 + (w * 16 + i) * 64 + lane] = au[i]; }
        __syncthreads();
#pragma unroll
        for (int ii = 0; ii < 2; ++ii) {
            const int i = 2 * w + ii; float sg = 0.f, su = 0.f;
#pragma unroll
            for (int ww = 0; ww < 8; ++ww) { sg += part[(ww * 16 + i) * 64 + lane]; su += part[8192 + (ww * 16 + i) * 64 + lane]; }
            mid_s[(size_t)(32 * rb + crow(i, h)) * DFF + j0 + r] = (bf16_t)(pk2(siluf_(sg) * su, 0.f) & 0xffffu);
        }
    }
}

constexpr int NPHASE = 2 + 9 * DEPTH;
__global__ void __launch_bounds__(NTHR) fwd_kernel(Args A) {
    extern __shared__ __attribute__((aligned(16))) unsigned char lds[];
    cg::grid_group grid = cg::this_grid();
    const int wvs__ = __builtin_amdgcn_readfirstlane((int)(threadIdx.x >> 6));
    for (int ph = A.ph_lo; ph < A.ph_hi; ++ph) {
        if (ph > A.ph_lo) grid.sync();
        if (ph == 0) { phase_prologue(A, lds, wvs__); continue; }
        if (ph == NPHASE - 1) { phase_final_norm(A_out(), A_in(32), wvs__); continue; }
        const int l = (ph - 1) / 9, sub = (ph - 1) % 9;
        const float* modl = (const float*)(A_ws() + WS_MOD) + (size_t)l * NSEQ * 6144;
        const float* xp = l == 0 ? A_in(0) : A_out() + O_YP;
        const float* xs = l == 0 ? A_in(1) : A_out() + O_YS;
        bf16_t* HB = (bf16_t*)(A_ws() + WS_HB);
        if (sub == 0) {
            phase_norm(xp, xs, A_in(10) + l * DM, modl, 0, 1, HB, wvs__);
        } else if (sub == 1) {
            pg8::Gemm g{HB, (const bf16_t*)(A_ws() + WS_WIN) + (size_t)l * NIN * DM, MROWS, NIN, DM};
            pg8::StaticOrder S; S.init(MROWS, NIN, gridDim.x, obid());
            pg8::EpiIn E{l};
            pg8::gemm_phase<pg8::EpiIn, pg8::StaticOrder, true, true>((LAS unsigned char*)lds, g, S, E, wvs__);
        } else if (sub == 2) {
            phase_prep(A, l, lds, wvs__);
        } else if (sub == 3) {
            phase_mix(A, l, lds, wvs__);
        } else if (sub == 4) {
            phase_post(A, l, wvs__);
        } else if (sub == 5 || sub == 8) {
            const bool ffo = (sub == 8);
            pg8::Gemm g{ffo ? (const bf16_t*)(A_ws() + WS_MID) : HB,
                        ffo ? (const bf16_t*)(A_ws() + WS_WFO) + (size_t)l * DM * DFF : (const bf16_t*)(A_ws() + WS_WOUT) + (size_t)l * DM * DM, MP, DM, ffo ? DFF : DM};
            pg8::StaticOrder S; S.init(MP, DM, gridDim.x, obid());
            pg8::EpiRes E{ffo ? A_out() + O_YP : xp, ffo ? A_out() + O_YS : xs, A_out(), modl + (ffo ? 5 : 2) * DM};
            pg8::gemm_phase<pg8::EpiRes, pg8::StaticOrder, true, true>((LAS unsigned char*)lds, g, S, E, wvs__);
            small_res(lds, g.A + (size_t)MP * g.K, g.K, g.Bt, ffo ? A_out() + O_YS : xs, A_out() + O_YS, modl + (ffo ? 5 : 2) * DM, wvs__);
        } else if (sub == 6) {
            phase_norm(A_out() + O_YP, A_out() + O_YS, A_in(29) + l * DM, modl, 3, 4, HB, wvs__);
        } else {
            pg8::Gemm g{HB, (const bf16_t*)(A_ws() + WS_WFI) + (size_t)l * NFI * DM, MP, NFI, DM};
            pg8::StaticOrder S; S.init(MP, NFI, gridDim.x, obid());
            pg8::EpiSwiglu E{(bf16_t*)(A_ws() + WS_MID)};
            pg8::gemm_phase<pg8::EpiSwiglu, pg8::StaticOrder, true, true>((LAS unsigned char*)lds, g, S, E, wvs__);
            small_swiglu(lds, HB + (size_t)MP * DM, g.Bt, (bf16_t*)(A_ws() + WS_MID) + (size_t)MP * DFF, wvs__);
        }
    }
}

extern "C" void kernel_launch(void* const* d_in, const int* in_sizes, int n_in, void* d_out, int out_size, void* d_ws, size_t ws_size, hipStream_t stream) {
    static int grid = 0;
    if (grid == 0) {
        if (n_in != 33 || (size_t)out_size != O_END || ws_size < WS_END2) {
            fprintf(stderr, "kernel_launch: unexpected shapes: n_in %d out %d ws %zu (need %zu)\n", n_in, out_size, ws_size, (size_t)WS_END); grid = -1; return; }
        int dev = 0, cus = 0, per_cu = 0;
        (void)hipGetDevice(&dev);
        (void)hipDeviceGetAttribute(&cus, hipDeviceAttributeMultiprocessorCount, dev);
        if (hipFuncSetAttribute((const void*)fwd_kernel, hipFuncAttributeMaxDynamicSharedMemorySize, LDS_BYTES) != hipSuccess) { fprintf(stderr, "kernel_launch: hipFuncSetAttribute failed\n"); grid = -1; return; }
        if (hipOccupancyMaxActiveBlocksPerMultiprocessor(&per_cu, (const void*)fwd_kernel, NTHR, LDS_BYTES) != hipSuccess || per_cu < 1) per_cu = 1;
        (void)hipGetLastError();
        grid = cus * per_cu;
        if (grid < 1) grid = 256;
    }
    if (grid < 0) return;
    Args a{};
    for (int i = 0; i < 33; ++i) a.in[i] = (const float*)d_in[i];
    a.out = (float*)d_out; a.ws = (unsigned char*)d_ws;
#if ONE_LAUNCH
    a.ph_lo = 0; a.ph_hi = NPHASE;
    void* args[] = {&a};
    hipError_t e = hipLaunchCooperativeKernel((const void*)fwd_kernel, dim3(grid), dim3(NTHR), args, LDS_BYTES, stream);
    if (e != hipSuccess) fprintf(stderr, "cooperative launch failed: %s (grid %d)\n", hipGetErrorString(e), grid);
#else
    for (int ph = 0; ph < NPHASE; ++ph) {
        a.ph_lo = ph; a.ph_hi = ph + 1;
        hipLaunchKernelGGL(fwd_kernel, dim3(grid), dim3(NTHR), LDS_BYTES, stream, a);
    }
#endif
}
```

```cpp
#include <hip/hip_runtime.h>
#include <hip/hip_cooperative_groups.h>
#include <cstdio>
#include <cstdint>
#include <cmath>
#include <cstddef>
namespace cg = cooperative_groups;

#ifndef ONE_LAUNCH
#define ONE_LAUNCH 1
#endif

constexpr int DM = 1024, NB = 16, SEQ = 4096, DEPTH = 4, DB = 8, DSEQ = 32, PAST = 2048;
constexpr int MP = NB * SEQ, MS = DB * DSEQ, MROWS = MP + MS;
constexpr int NSEQ = NB + DB;
constexpr int RWC = 896, INC = 3464, NIN = 3584, DFF = 2816, NFI = 5632;
constexpr int NWAVES = 8, NTHR = 512;
constexpr int LDS_BYTES = 147456;
constexpr float LOG2E = 1.4426950408889634f;
constexpr float QSCALE = 0.125f * LOG2E;

constexpr size_t O_YP = 0;
constexpr size_t O_YS = O_YP + (size_t)MP * DM;
constexpr size_t O_KP = O_YS + (size_t)MS * DM;
constexpr size_t SZ_KP = (size_t)NB * SEQ * 512;
constexpr size_t O_VP = O_KP + DEPTH * SZ_KP;
constexpr size_t O_LFP = O_VP + DEPTH * SZ_KP;
constexpr size_t SZ_LFP = (size_t)NB * SEQ * 8;
constexpr size_t O_RSP = O_LFP + DEPTH * SZ_LFP;
constexpr size_t SZ_RSP = (size_t)NB * 4 * 64 * 64;
constexpr size_t O_SHP = O_RSP + DEPTH * SZ_RSP;
constexpr size_t SZ_SHP = (size_t)NB * RWC;
constexpr size_t O_HSP = O_SHP + DEPTH * SZ_SHP;
constexpr size_t O_KS = O_HSP + DEPTH * SZ_RSP;
constexpr size_t SZ_KS = (size_t)DB * DSEQ * 512;
constexpr size_t O_VS = O_KS + DEPTH * SZ_KS;
constexpr size_t O_LFS = O_VS + DEPTH * SZ_KS;
constexpr size_t SZ_LFS = (size_t)DB * DSEQ * 8;
constexpr size_t O_RSS = O_LFS + DEPTH * SZ_LFS;
constexpr size_t SZ_RSS = (size_t)DB * 4 * 64 * 64;
constexpr size_t O_SHS = O_RSS + DEPTH * SZ_RSS;
constexpr size_t SZ_SHS = (size_t)DB * RWC;
constexpr size_t O_HSS = O_SHS + DEPTH * SZ_SHS;
constexpr size_t O_END = O_HSS + DEPTH * SZ_RSS;
static_assert(O_END == 342192128ull, "d_out map");

constexpr size_t al256(size_t x) { return (x + 255) & ~(size_t)255; }
constexpr size_t WS_MOD = 0;
constexpr size_t WS_LBS = al256(WS_MOD + (size_t)DEPTH * NSEQ * 6144 * 4);
constexpr size_t WS_WIN = al256(WS_LBS + (size_t)DEPTH * 256 * 4);
constexpr size_t WS_WOUT = al256(WS_WIN + (size_t)DEPTH * NIN * DM * 2);
constexpr size_t WS_WFI = al256(WS_WOUT + (size_t)DEPTH * DM * DM * 2);
constexpr size_t WS_WFO = al256(WS_WFI + (size_t)DEPTH * NFI * DM * 2);
constexpr size_t WS_CB = al256(WS_WFO + (size_t)DEPTH * DM * DFF * 2);
constexpr size_t WS_CBS = al256(WS_CB + (size_t)128 * 4096 * 4);
constexpr size_t WS_BON = al256(WS_CBS + (size_t)64 * 2112 * 4);
constexpr size_t WS_HB = al256(WS_BON + (size_t)MROWS * 4 * 4);
constexpr size_t WS_OHG = al256(WS_HB + (size_t)MROWS * DM * 2);
constexpr size_t WS_W = al256(WS_OHG + (size_t)MROWS * 256 * 4);
constexpr size_t WS_Q = al256(WS_W + (size_t)MROWS * 256 * 4);
constexpr size_t WS_PRW = al256(WS_Q + (size_t)MROWS * 512 * 2);
constexpr size_t WS_PHG = al256(WS_PRW + (size_t)MROWS * RWC * 2);
constexpr size_t WS_R = al256(WS_PHG + (size_t)MROWS * DM * 2);
constexpr size_t SZ_OP = al256((size_t)MROWS * 256 * 2);
constexpr size_t WS_END = WS_R + 6 * SZ_OP;
constexpr size_t WS_KN = WS_END + 4096;
constexpr size_t WS_CNT = WS_END + 8192;
constexpr size_t WS_KNE = WS_END + 16384;
constexpr size_t WS_KNC = WS_END + 24576;
constexpr size_t WS_END2 = WS_END + 32768;
constexpr size_t WS_MID = WS_Q;
static_assert(WS_MID + (size_t)MROWS * DFF * 2 <= WS_END, "MID overlay");

typedef unsigned short bf16_t;
typedef short bf16x8 __attribute__((ext_vector_type(8)));
typedef short s16x4 __attribute__((ext_vector_type(4)));
typedef float f32x4 __attribute__((ext_vector_type(4)));
typedef float f32x2 __attribute__((ext_vector_type(2)));
typedef float f32x16 __attribute__((ext_vector_type(16)));
typedef unsigned u32x4 __attribute__((ext_vector_type(4)));
typedef unsigned u32x2 __attribute__((ext_vector_type(2)));
typedef __bf16 bf16x2_t __attribute__((ext_vector_type(2)));
#define LAS __attribute__((address_space(3)))
#define DI __device__ __forceinline__

DI unsigned pk2(float lo, float hi) { f32x2 v = {lo, hi}; bf16x2_t b = __builtin_convertvector(v, bf16x2_t); return __builtin_bit_cast(unsigned, b); }
DI float bf2f(unsigned short b) { return __uint_as_float(((unsigned)b) << 16); }
DI float bflo(unsigned w) { return __uint_as_float(w << 16); }
DI float bfhi(unsigned w) { return __uint_as_float(w & 0xffff0000u); }
DI u32x4 pack8(f32x4 a, f32x4 b) { u32x4 w; w.x = pk2(a[0], a[1]); w.y = pk2(a[2], a[3]); w.z = pk2(b[0], b[1]); w.w = pk2(b[2], b[3]); return w; }
DI u32x2 pack4(f32x4 a) { u32x2 w; w.x = pk2(a[0], a[1]); w.y = pk2(a[2], a[3]); return w; }
DI f32x4 unpack4(u32x2 w) { return (f32x4){bflo(w.x), bfhi(w.x), bflo(w.y), bfhi(w.y)}; }
DI float sigmoidf_(float x) { return __builtin_amdgcn_rcpf(1.0f + __expf(-x)); }
DI float siluf_(float x) { return x * __builtin_amdgcn_rcpf(1.0f + __expf(-x)); }
DI float log_sigmoidf_(float x) { return fminf(x, 0.f) - __logf(1.0f + __expf(-fabsf(x))); }
DI float softplusf_(float x) { return fmaxf(x, 0.f) + log1pf(__expf(-fabsf(x))); }
DI float wave_sum(float v) {
#pragma unroll
    for (int o = 1; o < 64; o <<= 1) v += __shfl_xor(v, o);
    return v;
}
template <int CTRL> DI float dpp_add(float x) { const int y = __builtin_amdgcn_update_dpp(0, __float_as_int(x), CTRL, 0xF, 0xF, true); return x + __int_as_float(y); }
DI float row16_sum(float x) { x = dpp_add<0xB1>(x); x = dpp_add<0x4E>(x); x = dpp_add<0x124>(x); x = dpp_add<0x128>(x); return x; }
DI float wave_sum_fast(float x) { x = row16_sum(x); x += __shfl_xor(x, 16); x += __shfl_xor(x, 32); return x; }
DI int row_seq(int row) { return row < MP ? (row >> 12) : NB + ((row - MP) >> 5); }

struct Args {
    const float* in[33];
    float* out;
    unsigned char* ws;
    int ph_lo, ph_hi;
};


#define AS4 __attribute__((address_space(4)))
DI unsigned long long ka_u64(int off) { const AS4 unsigned char* p = (const AS4 unsigned char*)__builtin_amdgcn_kernarg_segment_ptr(); asm volatile("" : "+s"(p)); return *(const AS4 unsigned long long*)(p + off); }
#define AS1 __attribute__((address_space(1)))
DI const float* A_in(int i) { return (const float*)(const AS1 float*)ka_u64(8 * i); }
DI float* A_out() { return (float*)(AS1 float*)ka_u64(264); }
DI unsigned char* A_ws() { return (unsigned char*)(AS1 unsigned char*)ka_u64(272); }
DI int otid_(int wvs) { int t = (wvs << 6) | (int)__builtin_amdgcn_mbcnt_hi(~0u, __builtin_amdgcn_mbcnt_lo(~0u, 0u)); asm volatile("" : "+v"(t)); return t; }
#define otid() otid_(wvs__)
DI int obid() { int b = blockIdx.x; asm volatile("" : "+s"(b)); return b; }
static_assert(offsetof(Args, out) == 264 && offsetof(Args, ws) == 272 && sizeof(Args) == 288, "Args layout");

namespace pg8 {
#define PG8_LAS __attribute__((address_space(3)))
typedef unsigned short bf16_t;
typedef short bf16x8 __attribute__((ext_vector_type(8)));
typedef float f32x4 __attribute__((ext_vector_type(4)));
typedef unsigned u32x4 __attribute__((ext_vector_type(4)));
constexpr int BM = 256, BK = 64, HALF = 128, HTB = HALF * BK * 2  , STAGE_BYTES = 8 * HTB, NXCD = 8, WGM = 8;

__host__ __device__ __forceinline__ int lds_byte(int r, int c) { const int st = (r >> 4) * 2 + (c >> 5), rr = r & 15, cc = c & 31, ob = rr * 64 + cc * 2; return st * 1024 + (ob ^ (((ob >> 9) & 1) << 5)); }
__host__ __device__ __forceinline__ void stage_rc(int b, int& R, int& C) { const int st = b / 1024, sb = b % 1024, swz = sb ^ (((sb >> 9) & 1) << 5); R = (st >> 1) * 16 + swz / 64; C = (st & 1) * 32 + (swz % 64) / 2; }
__host__ __device__ __forceinline__ int perm32(int rho) { const int n = rho >> 4, i = rho & 15; return 8 * (i >> 2) + 4 * n + (i & 3); }

struct Unit { int pm, pn; };
struct Gemm { const bf16_t* A; const bf16_t* Bt; int M, N, K; };

struct StaticOrder {
    int nM, nN, nwg, G, c;
    __host__ __device__ void init(int M, int N, int G_, int c_) { nM = M / BM; nN = N / BM; nwg = nM * nN; G = G_; c = c_; }
    __host__ __device__ bool next(int i, Unit& u) const {
        const long L = (long)i * G + c; if (L >= nwg) return false;
        int wgid = (int)L; { const int q = nwg / NXCD, r = nwg % NXCD, xcd = wgid % NXCD, off = wgid / NXCD; wgid = (xcd < r ? xcd * (q + 1) : r * (q + 1) + (xcd - r) * q) + off; }
        const int nig = WGM * nN, gid = wgid / nig, fm = gid * WGM, gsz = (nM - fm) < WGM ? (nM - fm) : WGM;
        u.pm = fm + ((wgid % nig) % gsz); u.pn = (wgid % nig) / gsz; return true;
    }
    __device__ __forceinline__ void a_ready(const Unit&) const {}
    __device__ __forceinline__ void done(const Unit&) const {}
};
template <class Epi, class Sched, bool ALIGN_EPI = false, bool SP2 = false>
__device__ __forceinline__ void gemm_phase(PG8_LAS unsigned char* lds, const Gemm g, const Sched& S, const Epi& E, int wvs__) {
    const int tid = otid(), wid = __builtin_amdgcn_readfirstlane(tid >> 6), lane = tid & 63, wr = wid >> 2, wc = wid & 3, fr = lane & 15, fq = lane >> 4;
    const int K = g.K, nt = K / BK;
    unsigned voffA[2], voffB[2];
#pragma unroll
    for (int i = 0; i < 2; ++i) { int R, C; stage_rc(tid * 16 + i * 8192, R, C); const int Rb = Epi::PERM ? ((R & ~31) + perm32(R & 31)) : R;
        voffA[i] = (unsigned)(R * K + C) * 2u; voffB[i] = (unsigned)(Rb * K + C) * 2u; }
    const size_t kstep = (size_t)(BK * 2);
    const size_t hstep = (size_t)HALF * K * 2;
    const size_t tstep = 2 * hstep;
    const unsigned ldsw = (unsigned)wid * 1024u;
    const int aoff = lds_byte(wr * 64 + fr, fq * 8), boff = lds_byte(wc * 32 + fr, fq * 8);
#define PG8_SA(b, h) (((b) * 2 + (h)) * HTB)
#define PG8_SB(b, h) ((4 + (b) * 2 + (h)) * HTB)
#define PG8_STAGE(bufoff, gbase, voff) do { _Pragma("unroll") for (int _i = 0; _i < 2; ++_i) \
        __builtin_amdgcn_global_load_lds((const unsigned*)((const char*)(gbase) + (voff)[_i]), (PG8_LAS unsigned*)(lds + (bufoff) + ldsw + _i * 8192), 16, 0, 0); } while (0)
#define PG8_LDA(dst, b, h) do { _Pragma("unroll") for (int m = 0; m < 4; ++m) _Pragma("unroll") for (int k = 0; k < 2; ++k) dst[m][k] = *(const PG8_LAS bf16x8*)(lds + PG8_SA(b, h) + aoff + m * 2048 + k * 1024); } while (0)
#define PG8_LDB(dst, b, h) do { _Pragma("unroll") for (int n = 0; n < 2; ++n) _Pragma("unroll") for (int k = 0; k < 2; ++k) dst[n][k] = *(const PG8_LAS bf16x8*)(lds + PG8_SB(b, h) + boff + n * 2048 + k * 1024); } while (0)
#define PG8_MMA(ai, bj, At, Bt) do { __builtin_amdgcn_s_setprio(1); _Pragma("unroll") for (int m = 0; m < 4; ++m) _Pragma("unroll") for (int n = 0; n < 2; ++n) _Pragma("unroll") for (int k = 0; k < 2; ++k) \
        acc[ai][bj][m][n] = __builtin_amdgcn_mfma_f32_16x16x32_bf16(Bt[n][k], At[m][k], acc[ai][bj][m][n], 0, 0, 0); __builtin_amdgcn_s_setprio(0); } while (0)
#define PG8_WAIT_V(n) asm volatile("s_waitcnt vmcnt(" #n ")" ::: "memory")
#define PG8_WAIT_L(n) asm volatile("s_waitcnt lgkmcnt(" #n ")" ::: "memory")
#define PG8_BAR __builtin_amdgcn_s_barrier()
#define PG8_SCHED __builtin_amdgcn_sched_barrier(0)
    Unit cur, nxt; int ui = 0;
    if (!S.next(0, cur)) return;
    f32x4 acc[2][2][4][2];
#pragma unroll
    for (int a = 0; a < 2; ++a)
#pragma unroll
        for (int b = 0; b < 2; ++b)
#pragma unroll
            for (int m = 0; m < 4; ++m)
#pragma unroll
                for (int n = 0; n < 2; ++n) acc[a][b][m][n] = (f32x4){0.f, 0.f, 0.f, 0.f};
    bf16x8 At[4][2], B0[2][2], B1[2][2];
    const char* cA = (const char*)g.A + (size_t)cur.pm * tstep; const char* cB = (const char*)g.Bt + (size_t)cur.pn * tstep;
    S.a_ready(cur);
    if constexpr (SP2) {
        PG8_STAGE(PG8_SB(0, 0), cB, voffB); PG8_STAGE(PG8_SB(0, 1), cB + hstep, voffB); PG8_STAGE(PG8_SA(0, 0), cA, voffA); PG8_STAGE(PG8_SA(0, 1), cA + hstep, voffA);
        if (wr == 1) PG8_BAR;
        PG8_WAIT_V(2); PG8_BAR;
        PG8_STAGE(PG8_SB(1, 0), cB + kstep, voffB); PG8_STAGE(PG8_SA(1, 0), cA + kstep, voffA); PG8_STAGE(PG8_SB(1, 1), cB + hstep + kstep, voffB);
        PG8_WAIT_V(6); PG8_BAR;
    } else {
        PG8_STAGE(PG8_SB(0, 0), cB, voffB); PG8_STAGE(PG8_SA(0, 0), cA, voffA); PG8_STAGE(PG8_SB(0, 1), cB + hstep, voffB); PG8_STAGE(PG8_SA(0, 1), cA + hstep, voffA);
        if (wr == 1) PG8_BAR;
        PG8_WAIT_V(4); PG8_BAR;
        PG8_STAGE(PG8_SB(1, 0), cB + kstep, voffB); PG8_STAGE(PG8_SA(1, 0), cA + kstep, voffA); PG8_STAGE(PG8_SB(1, 1), cB + hstep + kstep, voffB);
        PG8_WAIT_V(6); PG8_BAR;
    }
    for (;;) {
        const bool has_next = S.next(ui + 1, nxt);
        const char* nA = has_next ? (const char*)g.A + (size_t)nxt.pm * tstep : cA; const char* nB = has_next ? (const char*)g.Bt + (size_t)nxt.pn * tstep : cB;
        for (int t = 0; t < nt; t += 2) {
            const bool last = (t == nt - 2);
            const char* a1 = cA + (size_t)(t + 1) * kstep;
            const char* a2 = last ? nA : cA + (size_t)(t + 2) * kstep; const char* b2 = last ? nB : cB + (size_t)(t + 2) * kstep;
            const char* a3 = a2 + kstep; const char* b3 = b2 + kstep;
            if (last && has_next) S.a_ready(nxt);
            if constexpr (SP2) {
            PG8_LDB(B0, 0, 0); PG8_LDB(B1, 0, 1); PG8_SCHED; PG8_LDA(At, 0, 0); PG8_STAGE(PG8_SA(1, 1), a1 + hstep, voffA);
            PG8_WAIT_V(8); PG8_WAIT_L(0); PG8_BAR; PG8_MMA(0, 0, At, B0); PG8_MMA(0, 1, At, B1); PG8_BAR; PG8_SCHED;
            PG8_LDA(At, 0, 1); PG8_STAGE(PG8_SB(0, 0), b2, voffB); PG8_STAGE(PG8_SB(0, 1), b2 + hstep, voffB); PG8_STAGE(PG8_SA(0, 0), a2, voffA);
            PG8_WAIT_V(8); PG8_WAIT_L(0); PG8_BAR; PG8_MMA(1, 0, At, B0); PG8_MMA(1, 1, At, B1); PG8_BAR; PG8_SCHED;
            PG8_LDB(B0, 1, 0); PG8_LDB(B1, 1, 1); PG8_SCHED; PG8_LDA(At, 1, 0); PG8_STAGE(PG8_SA(0, 1), a2 + hstep, voffA);
            PG8_WAIT_V(8); PG8_WAIT_L(0); PG8_BAR; PG8_MMA(0, 0, At, B0); PG8_MMA(0, 1, At, B1); PG8_BAR; PG8_SCHED;
            PG8_LDA(At, 1, 1); PG8_STAGE(PG8_SB(1, 0), b3, voffB); PG8_STAGE(PG8_SB(1, 1), b3 + hstep, voffB); PG8_STAGE(PG8_SA(1, 0), a3, voffA);
            PG8_WAIT_V(8); PG8_WAIT_L(0); PG8_BAR; PG8_MMA(1, 0, At, B0); PG8_MMA(1, 1, At, B1); PG8_BAR; PG8_SCHED;
            } else {
            PG8_LDB(B0, 0, 0); PG8_SCHED; PG8_LDA(At, 0, 0); PG8_STAGE(PG8_SA(1, 1), a1 + hstep, voffA);
            PG8_WAIT_L(8); PG8_BAR; PG8_WAIT_L(0); PG8_MMA(0, 0, At, B0); PG8_BAR; PG8_SCHED;
            PG8_LDB(B1, 0, 1); PG8_STAGE(PG8_SB(0, 0), b2, voffB);
            PG8_BAR; PG8_WAIT_L(0); PG8_MMA(0, 1, At, B1); PG8_BAR;
            PG8_LDA(At, 0, 1); PG8_STAGE(PG8_SA(0, 0), a2, voffA);
            PG8_BAR; PG8_WAIT_L(0); PG8_MMA(1, 0, At, B0); PG8_BAR; PG8_SCHED;
            PG8_STAGE(PG8_SB(0, 1), b2 + hstep, voffB);
            PG8_WAIT_V(6); PG8_BAR; PG8_MMA(1, 1, At, B1); PG8_BAR;
            PG8_LDB(B0, 1, 0); PG8_SCHED; PG8_LDA(At, 1, 0); PG8_STAGE(PG8_SA(0, 1), a2 + hstep, voffA);
            PG8_WAIT_L(8); PG8_BAR; PG8_WAIT_L(0); PG8_MMA(0, 0, At, B0); PG8_BAR; PG8_SCHED;
            PG8_LDB(B1, 1, 1); PG8_STAGE(PG8_SB(1, 0), b3, voffB);
            PG8_BAR; PG8_WAIT_L(0); PG8_MMA(0, 1, At, B1); PG8_BAR;
            PG8_LDA(At, 1, 1); PG8_STAGE(PG8_SA(1, 0), a3, voffA);
            PG8_BAR; PG8_WAIT_L(0); PG8_MMA(1, 0, At, B0); PG8_BAR; PG8_SCHED;
            PG8_STAGE(PG8_SB(1, 1), b3 + hstep, voffB);
            PG8_WAIT_V(6); PG8_BAR; PG8_MMA(1, 1, At, B1); PG8_BAR;
            }
        }
        if constexpr (ALIGN_EPI) { if (wr == 0) PG8_BAR; }
        if constexpr (!Epi::AFTER_DRAIN) { E(acc, cur, wr, wc, fr, fq); S.done(cur); }
        if (!has_next) break;
#pragma unroll
        for (int a = 0; a < 2; ++a)
#pragma unroll
            for (int b = 0; b < 2; ++b)
#pragma unroll
                for (int m = 0; m < 4; ++m)
#pragma unroll
                    for (int n = 0; n < 2; ++n) acc[a][b][m][n] = (f32x4){0.f, 0.f, 0.f, 0.f};
        cur = nxt; cA = nA; cB = nB; ++ui;
        if constexpr (ALIGN_EPI) { if (wr == 1) PG8_BAR; }
    }
    PG8_WAIT_V(0);
    if constexpr (!ALIGN_EPI) { if (wr == 0) PG8_BAR; }
    PG8_BAR;
    if constexpr (Epi::AFTER_DRAIN) { E.fused(acc, cur, wr, wc, fr, fq, lds, wid, lane); S.done(cur); }
#undef PG8_SA
#undef PG8_SB
#undef PG8_STAGE
#undef PG8_LDA
#undef PG8_LDB
#undef PG8_MMA
#undef PG8_WAIT_V
#undef PG8_WAIT_L
#undef PG8_BAR
#undef PG8_SCHED
}
}

namespace pg8 {
struct EpiIn {
    static constexpr bool PERM = true, AFTER_DRAIN = false;
    int l;
    __device__ __forceinline__ void operator()(const f32x4 (&acc)[2][2][4][2], const Unit& u, int wr, int wc, int fr, int fq) const {
        const int pn = u.pn;
        unsigned char* ws_ = A_ws(); float* out_ = A_out();
        bf16_t* Q = (bf16_t*)(ws_ + WS_Q); bf16_t* PRW = (bf16_t*)(ws_ + WS_PRW); bf16_t* PHG = (bf16_t*)(ws_ + WS_PHG);
        float* Kp = out_ + O_KP + (size_t)l * SZ_KP; float* Vp = out_ + O_VP + (size_t)l * SZ_KP; float* LFp = out_ + O_LFP + (size_t)l * SZ_LFP; float* SHp = out_ + O_SHP + (size_t)l * SZ_SHP;
        float* Ks = out_ + O_KS + (size_t)l * SZ_KS; float* Vs = out_ + O_VS + (size_t)l * SZ_KS; float* LFs = out_ + O_LFS + (size_t)l * SZ_LFS; float* SHs = out_ + O_SHS + (size_t)l * SZ_SHS;
        const float* bf = A_in(25) + l * 8;
        float kmx[2] = {0.f, 0.f};
#pragma unroll
        for (int ai = 0; ai < 2; ++ai)
#pragma unroll
            for (int m = 0; m < 4; ++m) {
                const int row = u.pm * BM + ai * HALF + wr * 64 + m * 16 + fr;
                const bool samp = row >= MP;
#pragma unroll
                for (int bj = 0; bj < 2; ++bj) {
                    const int col0 = pn * BM + bj * HALF + wc * 32 + 8 * fq;
                    const f32x4 v0 = acc[ai][bj][m][0], v1 = acc[ai][bj][m][1];
                    if (pn < 2) {
                        *(u32x4*)(Q + (size_t)row * 512 + col0) = pack8(v0 * QSCALE, v1 * QSCALE);
                    } else if (pn < 4) {
                        float* d = (samp ? Ks + (size_t)(row - MP) * 512 : Kp + (size_t)row * 512) + (col0 - 512);
                        *(f32x4*)d = v0; *(f32x4*)(d + 4) = v1;
                        float sq = ((v0[0] * v0[0] + v0[1] * v0[1]) + (v0[2] * v0[2] + v0[3] * v0[3])) + ((v1[0] * v1[0] + v1[1] * v1[1]) + (v1[2] * v1[2] + v1[3] * v1[3]));
                        sq += __shfl_xor(sq, 16); sq += __shfl_xor(sq, 32);
                        if (u.pm < MP / BM) kmx[bj] = fmaxf(kmx[bj], sq);
                        else {
#pragma unroll
                            for (int o = 1; o < 16; o <<= 1) sq = fmaxf(sq, __shfl_xor(sq, o));
                            if (fr == 0 && fq == 0) atomicMax((unsigned*)(ws_ + WS_KNE) + ((l * NSEQ + NB + ai * 4 + wr * 2 + (m >> 1)) * 8 + 4 * (pn - 2) + 2 * bj + (wc >> 1)) * 2 + (wc & 1), __float_as_uint(sq));
                        }
                    } else if (pn < 6) {
                        float* d = (samp ? Vs + (size_t)(row - MP) * 512 : Vp + (size_t)row * 512) + (col0 - 1024);
                        *(f32x4*)d = v0; *(f32x4*)(d + 4) = v1;
                    } else if (pn < 10) {
                        *(u32x4*)(PHG + (size_t)row * 1024 + (col0 - 1536)) = pack8(v0, v1);
                    } else {
                        const int c = col0 - 2560;
                        if (c < RWC) {
                            *(u32x4*)(PRW + (size_t)row * RWC + c) = pack8(v0, v1);
                            const bool last = samp ? (((row - MP) & 31) == 31) : ((row & 4095) == 4095);
                            if (last) { float* d = (samp ? SHs + (size_t)((row - MP) >> 5) * RWC : SHp + (size_t)(row >> 12) * RWC) + c; *(f32x4*)d = v0; *(f32x4*)(d + 4) = v1; }
                        } else if (c == RWC) {
                            f32x4 l0, l1;
#pragma unroll
                            for (int j = 0; j < 4; ++j) { l0[j] = log_sigmoidf_(v0[j] + bf[j]); l1[j] = log_sigmoidf_(v1[j] + bf[4 + j]); }
                            float* d = samp ? LFs + (size_t)(row - MP) * 8 : LFp + (size_t)row * 8;
                            *(f32x4*)d = l0; *(f32x4*)(d + 4) = l1;
                        }
                    }
                }
            }
        if (pn >= 2 && pn < 4 && u.pm < MP / BM) {
#pragma unroll
            for (int bj = 0; bj < 2; ++bj) {
                float mx = kmx[bj];
#pragma unroll
                for (int o = 1; o < 16; o <<= 1) mx = fmaxf(mx, __shfl_xor(mx, o));
                if (fr == 0 && fq == 0) atomicMax((unsigned*)(ws_ + WS_KNE) + ((l * NSEQ + (u.pm >> 4)) * 8 + 4 * (pn - 2) + 2 * bj + (wc >> 1)) * 2 + (wc & 1), __float_as_uint(mx));
            }
        }
    }
};
struct EpiRes {
    static constexpr bool PERM = false, AFTER_DRAIN = false;
    const float* xin_p; const float* xin_s; float* xout; const float* ga;
    __device__ __forceinline__ void operator()(const f32x4 (&acc)[2][2][4][2], const Unit& u, int wr, int wc, int fr, int fq) const {
        const float* gr = ga + (size_t)(u.pm >> 4) * 6144 + u.pn * BM + wc * 32 + 4 * fq;
        f32x4 g4[2][2];
#pragma unroll
        for (int bj = 0; bj < 2; ++bj)
#pragma unroll
            for (int n = 0; n < 2; ++n) g4[bj][n] = *(const f32x4*)(gr + bj * HALF + 16 * n);
        const size_t off0 = (size_t)(u.pm * BM + wr * 64 + fr) * DM + u.pn * BM + wc * 32 + 4 * fq;
        f32x4 xc[2][2], xn[2][2];
#pragma unroll
        for (int bj = 0; bj < 2; ++bj)
#pragma unroll
            for (int n = 0; n < 2; ++n) xc[bj][n] = *(const f32x4*)(xin_p + off0 + bj * HALF + 16 * n);
#pragma unroll
        for (int gi = 0; gi < 8; ++gi) {
            const int ai = gi >> 2, m = gi & 3;
            const size_t off = off0 + (size_t)(ai * HALF + m * 16) * DM;
            if (gi + 1 < 8) {
                const size_t offn = off0 + (size_t)(((gi + 1) >> 2) * HALF + ((gi + 1) & 3) * 16) * DM;
#pragma unroll
                for (int bj = 0; bj < 2; ++bj)
#pragma unroll
                    for (int n = 0; n < 2; ++n) xn[bj][n] = *(const f32x4*)(xin_p + offn + bj * HALF + 16 * n);
            }
#pragma unroll
            for (int bj = 0; bj < 2; ++bj)
#pragma unroll
                for (int n = 0; n < 2; ++n) { *(f32x4*)(xout + off + bj * HALF + 16 * n) = xc[bj][n] + g4[bj][n] * acc[ai][bj][m][n]; xc[bj][n] = xn[bj][n]; }
        }
    }
};
struct EpiSwiglu {
    static constexpr bool PERM = true, AFTER_DRAIN = false;
    bf16_t* O;
    __device__ __forceinline__ void operator()(const f32x4 (&acc)[2][2][4][2], const Unit& u, int wr, int wc, int fr, int fq) const {
        const int col0 = u.pn * HALF + wc * 32 + 8 * fq;
#pragma unroll
        for (int ai = 0; ai < 2; ++ai)
#pragma unroll
            for (int m = 0; m < 4; ++m) {
                const int row = u.pm * BM + ai * HALF + wr * 64 + m * 16 + fr;
                f32x4 o0, o1;
#pragma unroll
                for (int j = 0; j < 4; ++j) { o0[j] = siluf_(acc[ai][0][m][0][j]) * acc[ai][1][m][0][j]; o1[j] = siluf_(acc[ai][0][m][1][j]) * acc[ai][1][m][1][j]; }
                *(u32x4*)(O + (size_t)row * DFF + col0) = pack8(o0, o1);
            }
    }
};
}

DI void transpose_item(const float* W, int K, int N, bf16_t* WT, int src_n0, int ncols, int dst_row0, int kb, float* scr, int lane) {
    const int k0 = 64 * kb;
    const int nl = lane & 31;
#pragma unroll
    for (int i = 0; i < 32; ++i) { const int kk = 2 * i + (lane >> 5); scr[kk * 33 + nl] = (nl < ncols) ? W[(size_t)(k0 + kk) * N + src_n0 + nl] : 0.f; }
    asm volatile("s_waitcnt lgkmcnt(0)" ::: "memory");
    const int c = lane & 7;
#pragma unroll
    for (int j = 0; j < 4; ++j) {
        const int n = (lane >> 3) + 8 * j; const float* s = scr + (8 * c) * 33 + n;
        u32x4 o; o.x = pk2(s[0 * 33], s[1 * 33]); o.y = pk2(s[2 * 33], s[3 * 33]); o.z = pk2(s[4 * 33], s[5 * 33]); o.w = pk2(s[6 * 33], s[7 * 33]);
        if (n < ncols) *(u32x4*)(WT + (size_t)(dst_row0 + n) * K + k0 + 8 * c) = o;
    }
    asm volatile("s_waitcnt lgkmcnt(0)" ::: "memory");
}

DI void phase_prologue(const Args& A, unsigned char* lds, int wvs__) {
    const int tid = otid(), lane = tid & 63, wave = tid >> 6;
    const int gw = obid() * NWAVES + wave, NGW = gridDim.x * NWAVES;
    float* scr = (float*)(lds + wave * 8448);
    constexpr int I_IN = 109 * 16, I_OUT = 32 * 16, I_FI = 176 * 16, I_FO = 32 * 44, I_L = I_IN + I_OUT + I_FI + I_FO;
    for (int it = gw; it < DEPTH * I_L; it += NGW) {
        const int l = it / I_L; int r = it % I_L;
        if (r < I_IN) {
            const int cbi = r / 16, kb = r % 16; int src, dst, nc = 32;
            if (cbi < 16) { src = 896 + 32 * cbi; dst = 32 * cbi; }
            else if (cbi < 32) { src = 1408 + 32 * (cbi - 16); dst = 512 + 32 * (cbi - 16); }
            else if (cbi < 48) { src = 1920 + 32 * (cbi - 32); dst = 1024 + 32 * (cbi - 32); }
            else if (cbi < 80) { src = 2440 + 32 * (cbi - 48); dst = 1536 + 32 * (cbi - 48); }
            else if (cbi < 108) { src = 32 * (cbi - 80); dst = 2560 + 32 * (cbi - 80); }
            else { src = 2432; dst = 3456; nc = 8; }
            transpose_item(A_in(13) + (size_t)l * DM * INC, DM, INC, (bf16_t*)(A_ws() + WS_WIN) + (size_t)l * NIN * DM, src, nc, dst, kb, scr, lane);
            continue;
        }
        r -= I_IN;
        if (r < I_OUT) {
            const int cbi = r / 16, kb = r % 16;
            transpose_item(A_in(28) + (size_t)l * DM * DM, DM, DM, (bf16_t*)(A_ws() + WS_WOUT) + (size_t)l * DM * DM, 32 * cbi, 32, 32 * cbi, kb, scr, lane);
            continue;
        }
        r -= I_OUT;
        if (r < I_FI) {
            const int cbi = r / 16, kb = r % 16; const int n0 = 32 * cbi;
            int dst; if (n0 < DFF) dst = (n0 / 128) * 256 + (n0 % 128); else { const int j = n0 - DFF; dst = (j / 128) * 256 + 128 + (j % 128); }
            transpose_item(A_in(30) + (size_t)l * DM * NFI, DM, NFI, (bf16_t*)(A_ws() + WS_WFI) + (size_t)l * NFI * DM, n0, 32, dst, kb, scr, lane);
            continue;
        }
        r -= I_FI;
        { const int cbi = r / 44, kb = r % 44;
          transpose_item(A_in(31) + (size_t)l * DFF * DM, DFF, DM, (bf16_t*)(A_ws() + WS_WFO) + (size_t)l * DM * DFF, 32 * cbi, 32, 32 * cbi, kb, scr, lane); }
    }
    __syncthreads();
    if (obid() == 0 && tid < 4) ((unsigned*)(A_ws() + WS_CNT))[tid] = 0u;
    if (obid() == 0) for (int e = tid; e < DEPTH * NSEQ * 16; e += NTHR) ((float*)(A_ws() + WS_KNE))[e] = 0.f;
    for (int it = obid(); it < DEPTH * 64; it += gridDim.x) {
        float* red = (float*)lds;
        const int l = it >> 6, b = (it >> 3) & 7, h = it & 7;
        const float* ka = A_in(4) + ((size_t)l * DB + b) * PAST * 512 + h * 64;
        float mx = 0.f;
#pragma unroll 8
        for (int e = tid; e < PAST * 16; e += NTHR) {
            const f32x4 v = *(const f32x4*)(ka + (size_t)(e >> 4) * 512 + 4 * (e & 15));
            mx = fmaxf(mx, row16_sum((v[0] * v[0] + v[1] * v[1]) + (v[2] * v[2] + v[3] * v[3])));
        }
#pragma unroll
        for (int o = 1; o < 64; o <<= 1) mx = fmaxf(mx, __shfl_xor(mx, o));
        if (lane == 0) red[wave] = mx;
        __syncthreads();
        if (tid == 0) { float m = red[0]; for (int w = 1; w < 8; ++w) m = fmaxf(m, red[w]); ((float*)(A_ws() + WS_KNC))[it] = m; }
        __syncthreads();
    }
    if (obid() == 0 && tid < 256) {
        const float* lg = A_in(26); float v[4], mx = -1e30f;
#pragma unroll
        for (int l = 0; l < 4; ++l) { v[l] = lg[l * 256 + tid]; mx = fmaxf(mx, v[l]); }
        float s = 0.f;
#pragma unroll
        for (int l = 0; l < 4; ++l) { v[l] = __expf(v[l] - mx); s += v[l]; }
        float* lbs = (float*)(A_ws() + WS_LBS); float c = 0.f;
#pragma unroll
        for (int l = 0; l < 4; ++l) { if (l > 0) c += v[l] / s; lbs[l * 256 + tid] = c; }
    }
    float* tab = (float*)(lds + wave * 6144);
    float* part = (float*)(lds + 49152);
    for (int it = obid(); it < DEPTH * 96; it += gridDim.x) {
        const int l = it / 96, c0 = 64 * (it % 96);
        float acc[24];
#pragma unroll
        for (int s = 0; s < 24; ++s) acc[s] = 0.f;
        for (int rnd = 0; rnd < 2; ++rnd) {
            const int k0 = 128 * wave + 64 * rnd;
            for (int s = 0; s < 24; ++s) { const float cv = (s < NB) ? A_in(2)[s * DM + k0 + lane] : A_in(3)[(s - NB) * DM + k0 + lane]; tab[lane * 24 + s] = siluf_(cv); }
            asm volatile("s_waitcnt lgkmcnt(0)" ::: "memory");
            const float* wp = A_in(11) + ((size_t)l * DM + k0) * 6144 + c0 + lane;
#pragma unroll 16
            for (int kk = 0; kk < 64; ++kk) {
                const float wv = wp[(size_t)kk * 6144];
#pragma unroll
                for (int s4 = 0; s4 < 6; ++s4) { const f32x4 t4 = *(const f32x4*)(tab + kk * 24 + 4 * s4);
                    acc[4 * s4] += t4[0] * wv; acc[4 * s4 + 1] += t4[1] * wv; acc[4 * s4 + 2] += t4[2] * wv; acc[4 * s4 + 3] += t4[3] * wv; }
            }
            asm volatile("s_waitcnt lgkmcnt(0)" ::: "memory");
        }
#pragma unroll
        for (int s = 0; s < 24; ++s) part[(wave * 24 + s) * 64 + lane] = acc[s];
        __syncthreads();
        for (int e = tid; e < 24 * 64; e += NTHR) {
            const int s = e >> 6, cl = e & 63; float sum = A_in(12)[l * 6144 + c0 + cl];
#pragma unroll
            for (int w = 0; w < 8; ++w) sum += part[(w * 24 + s) * 64 + cl];
            ((float*)(A_ws() + WS_MOD))[((size_t)l * NSEQ + s) * 6144 + c0 + cl] = sum;
        }
        __syncthreads();
    }
}

DI void phase_norm(const float* xp, const float* xs, const float* g, const float* modl, int sh_idx, int sc_idx, bf16_t* out, int wvs__) {
    const int lane = otid() & 63, wave = otid() >> 6;
    const int gw = obid() * NWAVES + wave, NGW = gridDim.x * NWAVES;
    f32x4 g4[4];
#pragma unroll
    for (int j = 0; j < 4; ++j) g4[j] = *(const f32x4*)(g + 4 * (lane + 64 * j));
#define NRM_LD(ra_, VA, VB, SCA, SHA, SCB, SHB) do { const int rb_ = ((ra_) + NGW < MROWS) ? (ra_) + NGW : (ra_); \
        const float* xa_ = (ra_) < MP ? xp + (size_t)(ra_) * DM : xs + (size_t)((ra_) - MP) * DM; \
        const float* xb_ = rb_ < MP ? xp + (size_t)rb_ * DM : xs + (size_t)(rb_ - MP) * DM; \
        const float* ma_ = modl + (size_t)row_seq(ra_) * 6144; const float* mb_ = modl + (size_t)row_seq(rb_) * 6144; \
        _Pragma("unroll") for (int j = 0; j < 4; ++j) { const int col = 4 * (lane + 64 * j); \
            VA[j] = *(const f32x4*)(xa_ + col); VB[j] = *(const f32x4*)(xb_ + col); \
            SCA[j] = *(const f32x4*)(ma_ + sc_idx * DM + col); SHA[j] = *(const f32x4*)(ma_ + sh_idx * DM + col); \
            SCB[j] = *(const f32x4*)(mb_ + sc_idx * DM + col); SHB[j] = *(const f32x4*)(mb_ + sh_idx * DM + col); } } while (0)
    f32x4 va[4], vb[4], sca[4], sha[4], scb[4], shb[4], nva[4], nvb[4], nsca[4], nsha[4], nscb[4], nshb[4];
    int rowa = gw;
    if (rowa < MROWS) NRM_LD(rowa, va, vb, sca, sha, scb, shb);
    for (; rowa < MROWS; rowa += 2 * NGW) {
        const int rowb = rowa + NGW;
        const bool hasb = rowb < MROWS;
        if (rowa + 2 * NGW < MROWS) NRM_LD(rowa + 2 * NGW, nva, nvb, nsca, nsha, nscb, nshb);
        asm volatile("" ::: "memory");
        float sa = 0.f, sb = 0.f;
#pragma unroll
        for (int j = 0; j < 4; ++j) { sa += (va[j][0] * va[j][0] + va[j][1] * va[j][1]) + (va[j][2] * va[j][2] + va[j][3] * va[j][3]);
                                      sb += (vb[j][0] * vb[j][0] + vb[j][1] * vb[j][1]) + (vb[j][2] * vb[j][2] + vb[j][3] * vb[j][3]); }
        const float ra = rsqrtf(wave_sum_fast(sa) * (1.0f / DM) + 1e-6f), rbs = rsqrtf(wave_sum_fast(sb) * (1.0f / DM) + 1e-6f);
#pragma unroll
        for (int j = 0; j < 4; ++j) {
            const int col = 4 * (lane + 64 * j);
            const f32x4 ha = va[j] * ra * g4[j] * (sca[j] + 1.0f) + sha[j];
            *(u32x2*)(out + (size_t)rowa * DM + col) = pack4(ha);
            if (hasb) {
                const f32x4 hb = vb[j] * rbs * g4[j] * (scb[j] + 1.0f) + shb[j];
                *(u32x2*)(out + (size_t)rowb * DM + col) = pack4(hb);
            }
        }
#pragma unroll
        for (int j = 0; j < 4; ++j) { va[j] = nva[j]; vb[j] = nvb[j]; sca[j] = nsca[j]; sha[j] = nsha[j]; scb[j] = nscb[j]; shb[j] = nshb[j]; }
    }
#undef NRM_LD
}
DI void phase_final_norm(float* x, const float* g, int wvs__) {
    const int lane = otid() & 63, wave = otid() >> 6;
    const int gw = obid() * NWAVES + wave, NGW = gridDim.x * NWAVES;
    f32x4 g4[4];
#pragma unroll
    for (int j = 0; j < 4; ++j) g4[j] = *(const f32x4*)(g + 4 * (lane + 64 * j));
    for (int rowa = gw; rowa < MROWS; rowa += 2 * NGW) {
        const int rowb = rowa + NGW;
        const bool hasb = rowb < MROWS;
        float* xa = x + (size_t)rowa * DM; float* xb = x + (size_t)(hasb ? rowb : rowa) * DM;
        f32x4 va[4], vb[4]; float sa = 0.f, sb = 0.f;
#pragma unroll
        for (int j = 0; j < 4; ++j) { va[j] = *(const f32x4*)(xa + 4 * (lane + 64 * j)); vb[j] = *(const f32x4*)(xb + 4 * (lane + 64 * j)); }
        asm volatile("" ::: "memory");
#pragma unroll
        for (int j = 0; j < 4; ++j) { sa += (va[j][0] * va[j][0] + va[j][1] * va[j][1]) + (va[j][2] * va[j][2] + va[j][3] * va[j][3]);
                                      sb += (vb[j][0] * vb[j][0] + vb[j][1] * vb[j][1]) + (vb[j][2] * vb[j][2] + vb[j][3] * vb[j][3]); }
        const float ra = rsqrtf(wave_sum_fast(sa) * (1.0f / DM) + 1e-6f), rbs = rsqrtf(wave_sum_fast(sb) * (1.0f / DM) + 1e-6f);
#pragma unroll
        for (int j = 0; j < 4; ++j) { const int col = 4 * (lane + 64 * j); *(f32x4*)(xa + col) = va[j] * ra * g4[j]; if (hasb) *(f32x4*)(xb + col) = vb[j] * rbs * g4[j]; }
    }
}

DI void cumsum_item(const float* srcA, int LA, const float* srcB, int LB, float* dst, float* red  , int wvs__) {
    const int tid = otid(), lane = tid & 63, wave = tid >> 6;
    const int T = LA + LB;
    float v[8]; float run = 0.f;
#pragma unroll
    for (int j = 0; j < 8; ++j) { const int t = 8 * tid + j; float x = 0.f; if (t < LA) x = srcA[(size_t)t * 8]; else if (t < T) x = srcB[(size_t)(t - LA) * 8]; run += x; v[j] = run; }
    float inc = run;
#pragma unroll
    for (int o = 1; o < 64; o <<= 1) { const float n = __shfl_up(inc, o); if (lane >= o) inc += n; }
    if (lane == 63) red[wave] = inc;
    __syncthreads();
    float base = inc - run;
    for (int w = 0; w < wave; ++w) base += red[w];
#pragma unroll
    for (int j = 0; j < 8; ++j) { const int t = 8 * tid + j; if (t < T) dst[t] = -LOG2E * (base + v[j]); }
    __syncthreads();
}

DI void phase_prep(const Args& A, int l, unsigned char* lds, int wvs__) {
    const int tid = otid(), lane = tid & 63;
    float* outp = A_out();
    for (int it = obid(); it < 192; it += gridDim.x) {
        float* red = (float*)lds;
        if (it < 128) {
            const int b = it >> 3, h = it & 7;
            const float* src = outp + O_LFP + (size_t)l * SZ_LFP + (size_t)b * SEQ * 8 + h;
            cumsum_item(src, SEQ, src, 0, (float*)(A_ws() + WS_CB) + (size_t)it * 4096, red, wvs__);
        } else {
            const int i2 = it - 128, b = i2 >> 3, h = i2 & 7;
            const float* sa = A_in(6) + ((size_t)l * DB + b) * PAST * 8 + h;
            const float* sb = outp + O_LFS + (size_t)l * SZ_LFS + (size_t)b * DSEQ * 8 + h;
            cumsum_item(sa, PAST, sb, DSEQ, (float*)(A_ws() + WS_CBS) + (size_t)i2 * 2112, red, wvs__);
        }
    }
    const bf16_t* PRW = (const bf16_t*)(A_ws() + WS_PRW);
    const float* mu = A_in(14) + l * RWC;
    const float* shift_in = A_in(8) + (size_t)l * DB * RWC;
    bf16_t* R = (bf16_t*)(A_ws() + WS_R); bf16_t* KP = (bf16_t*)(A_ws() + WS_R + SZ_OP); bf16_t* KK = (bf16_t*)(A_ws() + WS_R + 2 * SZ_OP);
    bf16_t* KKA = (bf16_t*)(A_ws() + WS_R + 3 * SZ_OP); bf16_t* V = (bf16_t*)(A_ws() + WS_R + 4 * SZ_OP); bf16_t* G = (bf16_t*)(A_ws() + WS_R + 5 * SZ_OP);
    float* W = (float*)(A_ws() + WS_W); float* BON = (float*)(A_ws() + WS_BON);
    unsigned* inb2 = (unsigned*)(lds + 1024);
    const int col = tid & 255, th = tid >> 8, tk0 = 8 * th;
    unsigned* wl = (unsigned*)(lds + 16384);
    __syncthreads();
    {
        const float* w2 = A_in(16) + (size_t)l * 32 * 256; const float* a2 = A_in(18) + (size_t)l * 32 * 256; const float* g2 = A_in(19) + (size_t)l * 64 * 256;
        for (int e = tid; e < 64 * 256; e += NTHR) {
            const int i2 = e >> 8, c = e & 255;
            const float* src = i2 < 16 ? w2 + (2 * i2) * 256 + c : (i2 < 32 ? a2 + (2 * (i2 - 16)) * 256 + c : g2 + (2 * (i2 - 32)) * 256 + c);
            wl[e] = pk2(src[0], src[256]);
        }
    }
    const float mur = mu[col], muk = mu[256 + col], muv = mu[512 + col];
    const float w0c = A_in(15)[l * 256 + col], a0c = A_in(17)[l * 256 + col], kkc = A_in(20)[l * 256 + col], kac = A_in(21)[l * 256 + col], rkc = A_in(22)[l * 256 + col];
    for (int grp = obid(); grp < MROWS / 16; grp += gridDim.x) {
        __syncthreads();
        for (int e = tid; e < 64 * 16; e += NTHR) {
            const int tk = e & 15, i2 = e >> 4, row = grp * 16 + tk, c = 768 + 2 * i2;
            const unsigned pw_ = *(const unsigned*)(PRW + (size_t)row * RWC + c);
            const int pos = row < MP ? (row & 4095) : ((row - MP) & 31);
            float pv0, pv1;
            if (pos > 0) { const unsigned q_ = *(const unsigned*)(PRW + (size_t)(row - 1) * RWC + c); pv0 = bflo(q_); pv1 = bfhi(q_); }
            else if (row < MP) { pv0 = 0.f; pv1 = 0.f; }
            else { const float* sp = shift_in + (size_t)((row - MP) >> 5) * RWC + c; pv0 = sp[0]; pv1 = sp[1]; }
            const float p0 = bflo(pw_), p1 = bfhi(pw_);
            const float x0 = p0 + mu[c] * (pv0 - p0), x1 = p1 + mu[c + 1] * (pv1 - p1);
            float v0, v1;
            if (i2 < 16) { v0 = 1.0f - 2.0f * __builtin_amdgcn_rcpf(1.0f + __expf(2.0f * x0)); v1 = 1.0f - 2.0f * __builtin_amdgcn_rcpf(1.0f + __expf(2.0f * x1)); }
            else if (i2 < 32) { v0 = x0; v1 = x1; }
            else { v0 = sigmoidf_(x0); v1 = sigmoidf_(x1); }
            inb2[i2 * 16 + tk] = pk2(v0, v1);
        }
        __syncthreads();
        const int row0 = grp * 16 + tk0;
        const int pos0 = row0 < MP ? (row0 & 4095) : ((row0 - MP) & 31);
        float pv_r = 0.f, pv_k = 0.f, pv_v = 0.f;
        if (pos0 > 0) { const bf16_t* pp = PRW + (size_t)(row0 - 1) * RWC; pv_r = bf2f(pp[col]); pv_k = bf2f(pp[256 + col]); pv_v = bf2f(pp[512 + col]); }
        else if (row0 >= MP) { const float* sp = shift_in + (size_t)((row0 - MP) >> 5) * RWC; pv_r = sp[col]; pv_k = sp[256 + col]; pv_v = sp[512 + col]; }
        unsigned short qr_[8], qk_[8], qv_[8];
#pragma unroll
        for (int t = 0; t < 8; ++t) { const bf16_t* pr = PRW + (size_t)(row0 + t) * RWC; qr_[t] = pr[col]; qk_[t] = pr[256 + col]; qv_[t] = pr[512 + col]; }
        asm volatile("" ::: "memory");
        float lw[8], la[8], lg[8];
#pragma unroll
        for (int t = 0; t < 8; ++t) { lw[t] = 0.f; la[t] = 0.f; lg[t] = 0.f; }
#define DOT2(x_, w_, acc_) __builtin_amdgcn_fdot2_f32_bf16(__builtin_bit_cast(bf16x2_t, (unsigned)(x_)), __builtin_bit_cast(bf16x2_t, (unsigned)(w_)), (acc_), false)
#pragma unroll 4
        for (int i2 = 0; i2 < 16; ++i2) {
            const unsigned wp = wl[i2 * 256 + col], ap = wl[(16 + i2) * 256 + col];
            const u32x4 x0 = *(const u32x4*)(inb2 + i2 * 16 + tk0), x1 = *(const u32x4*)(inb2 + i2 * 16 + tk0 + 4);
            const u32x4 y0 = *(const u32x4*)(inb2 + (16 + i2) * 16 + tk0), y1 = *(const u32x4*)(inb2 + (16 + i2) * 16 + tk0 + 4);
#pragma unroll
            for (int t = 0; t < 4; ++t) { lw[t] = DOT2(x0[t], wp, lw[t]); lw[4 + t] = DOT2(x1[t], wp, lw[4 + t]); la[t] = DOT2(y0[t], ap, la[t]); la[4 + t] = DOT2(y1[t], ap, la[4 + t]); }
        }
#pragma unroll 4
        for (int i2 = 0; i2 < 32; ++i2) {
            const unsigned gp = wl[(32 + i2) * 256 + col];
            const u32x4 x0 = *(const u32x4*)(inb2 + (32 + i2) * 16 + tk0), x1 = *(const u32x4*)(inb2 + (32 + i2) * 16 + tk0 + 4);
#pragma unroll
            for (int t = 0; t < 4; ++t) { lg[t] = DOT2(x0[t], gp, lg[t]); lg[4 + t] = DOT2(x1[t], gp, lg[4 + t]); }
        }
#undef DOT2
#pragma unroll
        for (int t = 0; t < 8; ++t) {
            const int row = row0 + t;
            const float pr_r = bf2f(qr_[t]), pr_k = bf2f(qk_[t]), pr_v = bf2f(qv_[t]);
            const float xr = pr_r + mur * (pv_r - pr_r), xk = pr_k + muk * (pv_k - pr_k), xv = pr_v + muv * (pv_v - pr_v);
            pv_r = pr_r; pv_k = pr_k; pv_v = pr_v;
            const float e = 0.6065306597126334f * sigmoidf_(w0c + lw[t]);
            const float wdec = __expf(-e);
            const float a = sigmoidf_(a0c + la[t]);
            const float kkr = xk * kkc;
            const float ss = wave_sum_fast(kkr * kkr);
            const float kk = kkr * rsqrtf(fmaxf(ss, 1e-24f));
            const float kp = xk * (1.0f + (a - 1.0f) * kac);
            const float bon = wave_sum_fast(xr * kp * rkc);
            const size_t o = (size_t)row * 256 + col;
            const unsigned q0 = pk2(xr, kp), q1 = pk2(kk, kk * a), q2 = pk2(xv, lg[t]);
            R[o] = (bf16_t)(q0 & 0xffffu); KP[o] = (bf16_t)(q0 >> 16); KK[o] = (bf16_t)(q1 & 0xffffu);
            KKA[o] = (bf16_t)(q1 >> 16); V[o] = (bf16_t)(q2 & 0xffffu); G[o] = (bf16_t)(q2 >> 16);
            W[o] = wdec;
            if (lane == 0) BON[(size_t)row * 4 + (col >> 6)] = bon;
        }
    }
}


constexpr int SC_TOK0 = 336, SC_TOK1 = 208;
constexpr int SC_OP1 = 2 * 16 * SC_TOK0 * 4;
constexpr int SC_YP = SC_OP1 + 2 * 16 * SC_TOK1 * 4;
static_assert(SC_YP + 4 * 16384 <= LDS_BYTES, "scan LDS map");

DI void scan_items(const Args& A, int l, unsigned char* lds, int seq, int head, int vq, int wvs__) {
    const int tid = otid(), hw = tid >> 8, t256 = tid & 255, lane = tid & 63, wv = (tid >> 6) & 3;
    const int rowl = wv * 4 + (lane >> 4), kg = lane & 15;
    const int T = seq < NB ? SEQ : DSEQ;
    const int rowbase = seq < NB ? seq * SEQ : MP + (seq - NB) * DSEQ;
    const int nch = T / 16;
    const int sctok = hw == 0 ? SC_TOK0 : SC_TOK1;
    float* opb = (float*)(lds + hw * SC_OP1);
    float* ypb = (float*)(lds + SC_YP + hw * 32768);
    const int tok = t256 >> 4, part = t256 & 15;
    const int colh = head * 64 + 4 * part, colv = head * 64 + vq * 16 + 4 * part;
    const bf16_t* R = (const bf16_t*)(A_ws() + WS_R); const bf16_t* KP = (const bf16_t*)(A_ws() + WS_R + SZ_OP); const bf16_t* KK = (const bf16_t*)(A_ws() + WS_R + 2 * SZ_OP);
    const bf16_t* KKA = (const bf16_t*)(A_ws() + WS_R + 3 * SZ_OP); const bf16_t* V = (const bf16_t*)(A_ws() + WS_R + 4 * SZ_OP);
    const float* W = (const float*)(A_ws() + WS_W);
    const bf16_t* PHG = (const bf16_t*)(A_ws() + WS_PHG);
    float* YD = hw == 0 ? (float*)(A_ws() + WS_PRW) : (float*)(A_ws() + WS_OHG);
    f32x4 lb4 = {0.f, 0.f, 0.f, 0.f};
    if (hw == 1) lb4 = *(const f32x4*)((const float*)(A_ws() + WS_LBS) + l * 256 + colh);
    f32x2 Sa = {0.f, 0.f}, Sb = {0.f, 0.f};
    const int vrow = vq * 16 + rowl;
    if (seq >= NB) {
        const int b = seq - NB;
        if (hw == 0) { const f32x4 s4 = *(const f32x4*)(A_in(7) + ((((size_t)l * DB + b) * 4 + head) * 64 + vrow) * 64 + 4 * kg); Sa = (f32x2){s4[0], s4[1]}; Sb = (f32x2){s4[2], s4[3]}; }
        else { const float* sp = A_in(9) + (((size_t)l * DB + b) * 4 + head) * 4096 + vrow; Sa = (f32x2){sp[(4 * kg) * 64], sp[(4 * kg + 1) * 64]}; Sb = (f32x2){sp[(4 * kg + 2) * 64], sp[(4 * kg + 3) * 64]}; }
    }
    u32x2 pa, pb, pc, pd, pe; f32x4 pw;
    pa = pb = pc = pd = pe = (u32x2){0u, 0u}; pw = (f32x4){0.f, 0.f, 0.f, 0.f};
#define SC_LOAD(c) do { const size_t row_ = (size_t)(rowbase + (c) * 16 + tok); \
        if (hw == 0) { pa = *(const u32x2*)(R + row_ * 256 + colh); pb = *(const u32x2*)(KP + row_ * 256 + colh); pc = *(const u32x2*)(KK + row_ * 256 + colh); \
                       pd = *(const u32x2*)(KKA + row_ * 256 + colh); pw = *(const f32x4*)(W + row_ * 256 + colh); if (part < 4) pe = *(const u32x2*)(V + row_ * 256 + colv); } \
        else { pa = *(const u32x2*)(PHG + row_ * 1024 + colh); pb = *(const u32x2*)(PHG + row_ * 1024 + 256 + colh); if (part < 4) pe = *(const u32x2*)(PHG + row_ * 1024 + 512 + colv); } } while (0)
#define SC_STORE(bufi) do { float* d_ = opb + ((bufi) * 16 + tok) * sctok; \
        if (hw == 0) { *(f32x4*)(d_ + 4 * part) = unpack4(pa); *(f32x4*)(d_ + 64 + 4 * part) = pw; *(f32x4*)(d_ + 128 + 4 * part) = unpack4(pb); \
                       *(f32x4*)(d_ + 192 + 4 * part) = unpack4(pc); *(f32x4*)(d_ + 256 + 4 * part) = unpack4(pd); if (part < 4) *(f32x4*)(d_ + 320 + 4 * part) = unpack4(pe); } \
        else { const f32x4 fx_ = unpack4(pb); f32x4 f_, k_; \
               _Pragma("unroll") for (int j_ = 0; j_ < 4; ++j_) { const float sg_ = sigmoidf_(fx_[j_]); f_[j_] = lb4[j_] + (1.0f - lb4[j_]) * sg_; k_[j_] = (1.0f - lb4[j_]) * (1.0f - sg_); } \
               *(f32x4*)(d_ + 4 * part) = unpack4(pa); *(f32x4*)(d_ + 64 + 4 * part) = f_; *(f32x4*)(d_ + 128 + 4 * part) = k_; if (part < 4) *(f32x4*)(d_ + 192 + 4 * part) = unpack4(pe); } } while (0)
    __syncthreads();
    SC_LOAD(0); SC_STORE(0);
    __syncthreads();
    for (int c = 0; c < nch; ++c) {
        const bool more = (c + 1 < nch);
        if (more) SC_LOAD(c + 1);
        float* yp = ypb + (c & 1) * 4096 + rowl * 16 + kg;
        if (hw == 0) {
            const float* buf = opb + (c & 1) * 16 * SC_TOK0 + 4 * kg;
            const float* vb = opb + (c & 1) * 16 * SC_TOK0 + 320 + rowl;
#define RW_LD(s_, X) do { const float* tb_ = buf + (s_) * SC_TOK0; X##r = *(const f32x4*)tb_; X##w = *(const f32x4*)(tb_ + 64); X##p = *(const f32x4*)(tb_ + 128); \
                          X##k = *(const f32x4*)(tb_ + 192); X##a = *(const f32x4*)(tb_ + 256); X##v = vb[(s_) * SC_TOK0]; } while (0)
#define RW_STEP(s_, X) do { const f32x2 vv2_ = {X##v, X##v}; \
                const f32x2 pva_ = (f32x2){X##p[0], X##p[1]} * vv2_, pvb_ = (f32x2){X##p[2], X##p[3]} * vv2_; \
                f32x2 t_ = Sa * (f32x2){X##k[0], X##k[1]}; t_ = Sb * (f32x2){X##k[2], X##k[3]} + t_; \
                const float skk_ = row16_sum(t_[0] + t_[1]); const f32x2 sk2_ = {skk_, skk_}; \
                Sa = Sa * (f32x2){X##w[0], X##w[1]} + (pva_ - (f32x2){X##a[0], X##a[1]} * sk2_); \
                Sb = Sb * (f32x2){X##w[2], X##w[3]} + (pvb_ - (f32x2){X##a[2], X##a[3]} * sk2_); \
                f32x2 yy_ = Sa * (f32x2){X##r[0], X##r[1]}; yy_ = Sb * (f32x2){X##r[2], X##r[3]} + yy_; \
                yp[(s_) * 256] = yy_[0] + yy_[1]; } while (0)
            f32x4 Ar, Aw, Ap, Ak, Aa, Br, Bw, Bp, Bk, Ba; float Av, Bv;
            RW_LD(0, A);
#pragma unroll
            for (int s = 0; s < 16; s += 2) {
                RW_LD(s + 1, B);
                RW_STEP(s, A);
                if (s + 2 < 16) RW_LD(s + 2, A);
                RW_STEP(s + 1, B);
            }
#undef RW_LD
#undef RW_STEP
        } else {
            const float* buf = opb + (c & 1) * 16 * SC_TOK1 + 4 * kg;
            const float* vb = opb + (c & 1) * 16 * SC_TOK1 + 192 + rowl;
#define HG_LD(s_, X) do { const float* tb_ = buf + (s_) * SC_TOK1; X##q = *(const f32x4*)tb_; X##f = *(const f32x4*)(tb_ + 64); X##k = *(const f32x4*)(tb_ + 128); X##v = vb[(s_) * SC_TOK1]; } while (0)
#define HG_STEP(s_, X) do { const f32x2 iv2_ = {X##v, X##v}; \
                Sa = Sa * (f32x2){X##f[0], X##f[1]} + (f32x2){X##k[0], X##k[1]} * iv2_; \
                Sb = Sb * (f32x2){X##f[2], X##f[3]} + (f32x2){X##k[2], X##k[3]} * iv2_; \
                f32x2 yy_ = Sa * (f32x2){X##q[0], X##q[1]}; yy_ = Sb * (f32x2){X##q[2], X##q[3]} + yy_; \
                yp[(s_) * 256] = yy_[0] + yy_[1]; } while (0)
            f32x4 Aq, Af, Ak, Bq, Bf, Bk; float Av, Bv;
            HG_LD(0, A);
#pragma unroll
            for (int s = 0; s < 16; s += 2) {
                HG_LD(s + 1, B);
                HG_STEP(s, A);
                if (s + 2 < 16) HG_LD(s + 2, A);
                HG_STEP(s + 1, B);
            }
#undef HG_LD
#undef HG_STEP
        }
        if (more) SC_STORE((c + 1) & 1);
        __syncthreads();
        {
            const float* q = ypb + (c & 1) * 4096 + tok * 256 + part * 16;
            const f32x4 a0 = *(const f32x4*)q, a1 = *(const f32x4*)(q + 4), a2 = *(const f32x4*)(q + 8), a3 = *(const f32x4*)(q + 12);
            const f32x4 sm = (a0 + a1) + (a2 + a3);
            YD[(size_t)(rowbase + c * 16 + tok) * 256 + head * 64 + vq * 16 + part] = (sm[0] + sm[1]) + (sm[2] + sm[3]);
        }
    }
#undef SC_LOAD
#undef SC_STORE
    if (hw == 0) {
        float* d = (seq < NB ? A_out() + O_RSP + (size_t)l * SZ_RSP + (((size_t)seq * 4 + head) * 64 + vrow) * 64
                             : A_out() + O_RSS + (size_t)l * SZ_RSS + (((size_t)(seq - NB) * 4 + head) * 64 + vrow) * 64) + 4 * kg;
        *(f32x4*)d = (f32x4){Sa[0], Sa[1], Sb[0], Sb[1]};
    } else {
        float* d = (seq < NB ? A_out() + O_HSP + (size_t)l * SZ_RSP + ((size_t)seq * 4 + head) * 4096
                             : A_out() + O_HSS + (size_t)l * SZ_RSS + ((size_t)(seq - NB) * 4 + head) * 4096) + vrow;
        d[(4 * kg) * 64] = Sa[0]; d[(4 * kg + 1) * 64] = Sa[1]; d[(4 * kg + 2) * 64] = Sb[0]; d[(4 * kg + 3) * 64] = Sb[1];
    }
}

#define MFMA32(a, b, c) __builtin_amdgcn_mfma_f32_32x32x16_bf16((a), (b), (c), 0, 0, 0)
typedef short v4i16_t __attribute__((ext_vector_type(4)));
DI int crow(int i, int h) { return (i & 3) + 8 * (i >> 2) + 4 * h; }
DI void attn_unit(unsigned char* lds, const bf16_t* Q, int nq, const float* KA, const float* VA, int LA, const float* KB, const float* VB, int LB,
                  const float* cb, int qoff, float kmax, bf16_t* O, int wvs__) {
    const int tid = otid(), lane = tid & 63, wid = tid >> 6, r = lane & 31, h = lane >> 5;
    const int Ltot = LA + LB, NT = (Ltot + 63) >> 6;
    const bool active = (32 * wid < nq);
    const int qmin = qoff + 32 * wid;
    bf16x8 qf[4];
    float qn2 = 0.f;
#pragma unroll
    for (int ks = 0; ks < 4; ++ks) {
        qf[ks] = (bf16x8){0, 0, 0, 0, 0, 0, 0, 0};
        if (active) qf[ks] = *(const bf16x8*)(Q + (size_t)(32 * wid + r) * 512 + 16 * ks + 8 * h);
#pragma unroll
        for (int j = 0; j < 8; ++j) { const float qv = bf2f((unsigned short)qf[ks][j]); qn2 += qv * qv; }
    }
    qn2 += __shfl_xor(qn2, 32);
    const float cbq = cb[active ? qmin + r : qoff];
    const float mf = cbq + sqrtf(qn2) * kmax * 1.02f + 1.0f;
    int t0;
    {
        volatile int* slot2 = (volatile int*)(lds + 36880);
        __syncthreads();
        if (wid == 0) {
            int ke = 64 * lane + 63; ke = ke < Ltot - 1 ? ke : Ltot - 1;
            const bool ok = (lane < NT) && (cb[ke] - cb[qoff] >= -126.0f);
            const unsigned long long bal = __ballot(ok);
            if (lane == 0) *slot2 = bal ? (int)__builtin_ctzll(bal) : NT - 1;
        }
        __syncthreads();
        t0 = *slot2;
    }
    f32x16 o0, o1;
#pragma unroll
    for (int i = 0; i < 16; ++i) { o0[i] = 0.f; o1[i] = 0.f; }
    float lsum = 0.f;
    const int krow_l = tid & 63, kch = tid >> 6;
    const int vrow_l = (wid & 3) * 16 + (lane >> 2), vcol = (wid >> 2) * 32 + (lane & 3) * 8;
    f32x4 k0, k1, v0, v1; float bv = 0.f;
#define AT_LOAD(t) do { int kr_ = 64 * (t) + krow_l; kr_ = kr_ < Ltot ? kr_ : Ltot - 1; \
        const float* s_ = (kr_ < LA ? KA + (size_t)kr_ * 512 : KB + (size_t)(kr_ - LA) * 512) + kch * 8; k0 = *(const f32x4*)s_; k1 = *(const f32x4*)(s_ + 4); \
        int vr_ = 64 * (t) + vrow_l; vr_ = vr_ < Ltot ? vr_ : Ltot - 1; \
        const float* sv_ = (vr_ < LA ? VA + (size_t)vr_ * 512 : VB + (size_t)(vr_ - LA) * 512) + vcol; v0 = *(const f32x4*)sv_; v1 = *(const f32x4*)(sv_ + 4); \
        if (tid < 64) { const int kb_ = 64 * (t) + tid; bv = kb_ < Ltot ? cb[kb_] : 0.f; } } while (0)
#define AT_STORE(b) do { *(u32x4*)(lds + (b) * 8192 + tid * 16) = pack8(k0, k1); *(u32x4*)(lds + 16384 + (b) * 8192 + tid * 16) = pack8(v0, v1); \
        if (tid < 64) *(float*)(lds + 32768 + (b) * 256 + tid * 4) = bv; } while (0)
    AT_LOAD(t0); AT_STORE(t0 & 1);
    __syncthreads();
    const int tq = (lane & 15) >> 2, tp = lane & 3, tblk = (lane >> 4) & 1;
    for (int t = t0; t < NT; ++t) {
        const int b = t & 1;
        const bool more = (t + 1 < NT);
        if (more) AT_LOAD(t + 1);
        if (active && 64 * t <= qmin + 31) {
            const unsigned char* Kimg = lds + b * 8192;
            const float* Bimg = (const float*)(lds + 32768 + b * 256);
            f32x16 st0, st1;
#pragma unroll
            for (int g = 0; g < 4; ++g) {
                const f32x4 b0 = *(const f32x4*)(Bimg + 8 * g + 4 * h), b1 = *(const f32x4*)(Bimg + 32 + 8 * g + 4 * h);
#pragma unroll
                for (int j = 0; j < 4; ++j) { st0[4 * g + j] = b0[j] - mf; st1[4 * g + j] = b1[j] - mf; }
            }
#pragma unroll
            for (int ks = 0; ks < 4; ++ks) {
                const bf16x8 ka = *(const bf16x8*)(Kimg + (2 * ks + h) * 1024 + r * 16);
                const bf16x8 kb2 = *(const bf16x8*)(Kimg + (2 * ks + h) * 1024 + r * 16 + 512);
                st0 = MFMA32(ka, qf[ks], st0); st1 = MFMA32(kb2, qf[ks], st1);
            }
            if (64 * t + 63 > qmin || 64 * t + 63 >= Ltot) {
                int lim = qmin + r; lim = lim < Ltot - 1 ? lim : Ltot - 1;
#pragma unroll
                for (int i = 0; i < 16; ++i) { const int kv = 64 * t + crow(i, h); if (kv > lim) st0[i] = -INFINITY; if (kv + 32 > lim) st1[i] = -INFINITY; }
            }
            float ls = 0.f;
#pragma unroll
            for (int i = 0; i < 16; ++i) { st0[i] = __builtin_amdgcn_exp2f(st0[i]); st1[i] = __builtin_amdgcn_exp2f(st1[i]); ls += st0[i] + st1[i]; }
            lsum += ls;
            bf16x8 pf[4];
            { u32x4 w;
              w.x = pk2(st0[0], st0[1]); w.y = pk2(st0[2], st0[3]); w.z = pk2(st0[4], st0[5]); w.w = pk2(st0[6], st0[7]); pf[0] = __builtin_bit_cast(bf16x8, w);
              w.x = pk2(st0[8], st0[9]); w.y = pk2(st0[10], st0[11]); w.z = pk2(st0[12], st0[13]); w.w = pk2(st0[14], st0[15]); pf[1] = __builtin_bit_cast(bf16x8, w);
              w.x = pk2(st1[0], st1[1]); w.y = pk2(st1[2], st1[3]); w.z = pk2(st1[4], st1[5]); w.w = pk2(st1[6], st1[7]); pf[2] = __builtin_bit_cast(bf16x8, w);
              w.x = pk2(st1[8], st1[9]); w.y = pk2(st1[10], st1[11]); w.z = pk2(st1[12], st1[13]); w.w = pk2(st1[14], st1[15]); pf[3] = __builtin_bit_cast(bf16x8, w); }
            LAS unsigned char* Vimg = (LAS unsigned char*)lds + 16384 + b * 8192 + (4 * h + tq) * 64 + tblk * 32 + tp * 8;
#pragma unroll
            for (int ks = 0; ks < 4; ++ks) {
                const v4i16_t lo0 = __builtin_amdgcn_ds_read_tr16_b64_v4i16((LAS v4i16_t*)(Vimg + ks * 1024));
                const v4i16_t hi0 = __builtin_amdgcn_ds_read_tr16_b64_v4i16((LAS v4i16_t*)(Vimg + ks * 1024 + 512));
                const v4i16_t lo1 = __builtin_amdgcn_ds_read_tr16_b64_v4i16((LAS v4i16_t*)(Vimg + 4096 + ks * 1024));
                const v4i16_t hi1 = __builtin_amdgcn_ds_read_tr16_b64_v4i16((LAS v4i16_t*)(Vimg + 4096 + ks * 1024 + 512));
                const bf16x8 vf0 = (bf16x8){lo0[0], lo0[1], lo0[2], lo0[3], hi0[0], hi0[1], hi0[2], hi0[3]};
                const bf16x8 vf1 = (bf16x8){lo1[0], lo1[1], lo1[2], lo1[3], hi1[0], hi1[1], hi1[2], hi1[3]};
                o0 = MFMA32(vf0, pf[ks], o0); o1 = MFMA32(vf1, pf[ks], o1);
            }
        }
        if (more) AT_STORE(b ^ 1);
        __syncthreads();
    }
#undef AT_LOAD
#undef AT_STORE
    if (active) {
        lsum += __shfl_xor(lsum, 32);
        const float inv = 1.0f / lsum;
        bf16_t* orow = O + (size_t)(32 * wid + r) * DM;
#pragma unroll
        for (int g = 0; g < 4; ++g) {
            const f32x4 a = (f32x4){o0[4 * g], o0[4 * g + 1], o0[4 * g + 2], o0[4 * g + 3]} * inv;
            const f32x4 c = (f32x4){o1[4 * g], o1[4 * g + 1], o1[4 * g + 2], o1[4 * g + 3]} * inv;
            *(u32x2*)(orow + 8 * g + 4 * h) = pack4(a);
            *(u32x2*)(orow + 32 + 8 * g + 4 * h) = pack4(c);
        }
    }
}

DI void phase_mix(const Args& A, int l, unsigned char* lds, int wvs__) {
    for (int it = obid(); it < 384; it += gridDim.x) {
        int seq, head, vq;
        if (it < 256) { seq = it >> 4; head = (it >> 2) & 3; vq = it & 3; }
        else { const int i2 = it - 256; seq = NB + (i2 >> 4); head = (i2 >> 2) & 3; vq = i2 & 3; }
        scan_items(A, l, lds, seq, head, vq, wvs__);
        __syncthreads();
    }
    const bf16_t* Qb = (const bf16_t*)(A_ws() + WS_Q);
    bf16_t* HB = (bf16_t*)(A_ws() + WS_HB);
    const float* KNE = (const float*)(A_ws() + WS_KNE) + (size_t)l * NSEQ * 16;
    const float* KNC = (const float*)(A_ws() + WS_KNC) + l * 64;
    unsigned* cnt = (unsigned*)(A_ws() + WS_CNT) + l;
    volatile unsigned* slot = (volatile unsigned*)(lds + 36864);
    unsigned nxt = 0u;
    if (otid() == 0) nxt = __hip_atomic_fetch_add(cnt, 1u, __ATOMIC_RELAXED, __HIP_MEMORY_SCOPE_AGENT);
    for (;;) {
        __syncthreads();
        if (otid() == 0) *slot = nxt;
        __syncthreads();
        const int idx = (int)*slot;
        if (idx >= 64 + 2048) break;
        if (otid() == 0) nxt = __hip_atomic_fetch_add(cnt, 1u, __ATOMIC_RELAXED, __HIP_MEMORY_SCOPE_AGENT);
        if (idx < 64) {
            const int b = idx >> 3, h = idx & 7;
            const float* Ka = A_in(4) + ((size_t)l * DB + b) * PAST * 512 + h * 64;
            const float* Va = A_in(5) + ((size_t)l * DB + b) * PAST * 512 + h * 64;
            const float* Kn = A_out() + O_KS + (size_t)l * SZ_KS + (size_t)b * DSEQ * 512 + h * 64;
            const float* Vn = A_out() + O_VS + (size_t)l * SZ_KS + (size_t)b * DSEQ * 512 + h * 64;
            const float* cb = (const float*)(A_ws() + WS_CBS) + (size_t)idx * 2112;
            const size_t row0 = (size_t)MP + b * DSEQ;
            attn_unit(lds, Qb + row0 * 512 + h * 64, 32, Ka, Va, PAST, Kn, Vn, DSEQ, cb, PAST, sqrtf(fmaxf(KNC[idx], KNE[((NB + b) * 8 + h) * 2] + KNE[((NB + b) * 8 + h) * 2 + 1])), HB + row0 * DM + 256 + h * 64, wvs__);
        } else {
            const int i = idx - 64, qb = 15 - (i >> 7), bh = i & 127, b = bh >> 3, h = bh & 7;
            const float* Kb = A_out() + O_KP + (size_t)l * SZ_KP + (size_t)b * SEQ * 512 + h * 64;
            const float* Vb = A_out() + O_VP + (size_t)l * SZ_KP + (size_t)b * SEQ * 512 + h * 64;
            const float* cb = (const float*)(A_ws() + WS_CB) + (size_t)bh * 4096;
            const size_t row0 = (size_t)b * SEQ + 256 * qb;
            attn_unit(lds, Qb + row0 * 512 + h * 64, 256, Kb, Vb, 256 * qb + 256, Kb, Vb, 0, cb, 256 * qb, sqrtf(KNE[(b * 8 + h) * 2] + KNE[(b * 8 + h) * 2 + 1]), HB + row0 * DM + 256 + h * 64, wvs__);
        }
    }
}

DI void phase_post(const Args& A, int l, int wvs__) {
    const int tid = otid(), col = tid & 255, th = tid >> 8;
    const float* YRW = (const float*)(A_ws() + WS_PRW); const float* OHG = (const float*)(A_ws() + WS_OHG);
    const bf16_t* V = (const bf16_t*)(A_ws() + WS_R + 4 * SZ_OP); const bf16_t* G = (const bf16_t*)(A_ws() + WS_R + 5 * SZ_OP);
    const float* BON = (const float*)(A_ws() + WS_BON); const bf16_t* PHG = (const bf16_t*)(A_ws() + WS_PHG);
    bf16_t* HB = (bf16_t*)(A_ws() + WS_HB);
    const float lnw = A_in(23)[l * 256 + col], lnb = A_in(24)[l * 256 + col], ng = A_in(27)[l * 256 + col];
#define POST_LD(r0_, Y, OG, BN, VV, GT, GG) do { _Pragma("unroll") for (int k = 0; k < 4; ++k) { const size_t o_ = (size_t)((r0_) + k) * 256 + col; \
        Y[k] = YRW[o_]; OG[k] = OHG[o_]; BN[k] = BON[(size_t)((r0_) + k) * 4 + (col >> 6)]; VV[k] = V[o_]; GT[k] = G[o_]; GG[k] = PHG[(size_t)((r0_) + k) * 1024 + 768 + col]; } } while (0)
    float y[4], og[4], bon[4], yn_[4], ogn_[4], bonn_[4]; bf16_t vv[4], gt[4], gg[4], vvn_[4], gtn_[4], ggn_[4];
    const int stride = 8 * gridDim.x;
    int row0 = (obid() * 2 + th) * 4;
    if (row0 < MROWS) POST_LD(row0, y, og, bon, vv, gt, gg);
    for (; row0 < MROWS; row0 += stride) {
        const bool more = row0 + stride < MROWS;
        if (more) POST_LD(row0 + stride, yn_, ogn_, bonn_, vvn_, gtn_, ggn_);
        asm volatile("" ::: "memory");
        float mean[4], ms[4], var[4];
#pragma unroll
        for (int k = 0; k < 4; ++k) { mean[k] = wave_sum_fast(y[k]) * (1.0f / 64.0f); ms[k] = wave_sum_fast(og[k] * og[k]) * (1.0f / 64.0f); }
#pragma unroll
        for (int k = 0; k < 4; ++k) { const float d = y[k] - mean[k]; var[k] = wave_sum_fast(d * d) * (1.0f / 64.0f); }
#pragma unroll
        for (int k = 0; k < 4; ++k) {
            const float yn = (y[k] - mean[k]) * rsqrtf(var[k] + 64e-5f) * lnw + lnb;
            const float res = (yn + bon[k] * bf2f(vv[k])) * bf2f(gt[k]);
            const float r2 = og[k] * rsqrtf(ms[k] + 1e-6f) * ng * siluf_(bf2f(gg[k]));
            HB[(size_t)(row0 + k) * DM + col] = (bf16_t)(pk2(res, 0.f) & 0xffffu);
            HB[(size_t)(row0 + k) * DM + 768 + col] = (bf16_t)(pk2(r2, 0.f) & 0xffffu);
        }
#pragma unroll
        for (int k = 0; k < 4; ++k) { y[k] = yn_[k]; og[k] = ogn_[k]; bon[k] = bonn_[k]; vv[k] = vvn_[k]; gt[k] = gtn_[k]; gg[k] = ggn_[k]; }
    }
#undef POST_LD
}

DI f32x16 small_tile(const bf16_t* ap, const bf16_t* bp, int ks0, int nks) {
    f32x16 acc;
#pragma unroll
    for (int i = 0; i < 16; ++i) acc[i] = 0.f;
#pragma unroll 8
    for (int ks = ks0; ks < ks0 + nks; ++ks) {
        const bf16x8 a = *(const bf16x8*)(ap + 16 * ks), b = *(const bf16x8*)(bp + 16 * ks);
        acc = MFMA32(a, b, acc);
    }
    return acc;
}
DI void small_res(unsigned char* lds, const bf16_t* Asamp, int K, const bf16_t* Wt, const float* xin_s, float* xout_s, const float* ga, int wvs__) {
    const int lane = otid() & 63, r = lane & 31, h = lane >> 5, w = wvs__;
    float* part = (float*)lds;
    const int nks = K / 128;
    for (int task = obid(); task < 256; task += gridDim.x) {
        const int rb = task >> 5, cbk = task & 31;
        const f32x16 acc = small_tile(Asamp + (size_t)(32 * rb + r) * K + 8 * h, Wt + (size_t)(32 * cbk + r) * K + 8 * h, w * nks, nks);
        __syncthreads();
#pragma unroll
        for (int i = 0; i < 16; ++i) part[(w * 16 + i) * 64 + lane] = acc[i];
        __syncthreads();
        const int col = 32 * cbk + r;
        const float g = ga[(size_t)(NB + rb) * 6144 + col];
#pragma unroll
        for (int ii = 0; ii < 2; ++ii) {
            const int i = 2 * w + ii; float sum = 0.f;
#pragma unroll
            for (int ww = 0; ww < 8; ++ww) sum += part[(ww * 16 + i) * 64 + lane];
            const size_t o = (size_t)(32 * rb + crow(i, h)) * DM + col; xout_s[o] = xin_s[o] + g * sum;
        }
    }
}
DI void small_swiglu(unsigned char* lds, const bf16_t* Asamp, const bf16_t* Wt, bf16_t* mid_s, int wvs__) {
    const int lane = otid() & 63, r = lane & 31, h = lane >> 5, w = wvs__;
    float* part = (float*)lds;
    for (int task = obid(); task < 704; task += gridDim.x) {
        const int rb = task / 88, jb = task % 88, j0 = 32 * jb, T = j0 >> 7, c = j0 & 127;
        const bf16_t* ap = Asamp + (size_t)(32 * rb + r) * DM + 8 * h;
        const f32x16 ag = small_tile(ap, Wt + (size_t)(256 * T + c + r) * DM + 8 * h, w * 8, 8);
        const f32x16 au = small_tile(ap, Wt + (size_t)(256 * T + 128 + c + r) * DM + 8 * h, w * 8, 8);
        __syncthreads();
#pragma unroll
        for (int i = 0; i < 16; ++i) { part[(w * 16 + i) * 64 + lane] = ag[i]; part[8192 + (w * 16 + i) * 64 + lane] = au[i]; }
        __syncthreads();
#pragma unroll
        for (int ii = 0; ii < 2; ++ii) {
            const int i = 2 * w + ii; float sg = 0.f, su = 0.f;
#pragma unroll
            for (int ww = 0; ww < 8; ++ww) { sg += part[(ww * 16 + i) * 64 + lane]; su += part[8192 + (ww * 16 + i) * 64 + lane]; }
            mid_s[(size_t)(32 * rb + crow(i, h)) * DFF + j0 + r] = (bf16_t)(pk2(siluf_(sg) * su, 0.f) & 0xffffu);
        }
    }
}

constexpr int NPHASE = 2 + 9 * DEPTH;
__global__ void __launch_bounds__(NTHR) fwd_kernel(Args A) {
    extern __shared__ __attribute__((aligned(16))) unsigned char lds[];
    cg::grid_group grid = cg::this_grid();
    const int wvs__ = __builtin_amdgcn_readfirstlane((int)(threadIdx.x >> 6));
    for (int ph = A.ph_lo; ph < A.ph_hi; ++ph) {
        if (ph > A.ph_lo) grid.sync();
        if (ph == 0) { phase_prologue(A, lds, wvs__); continue; }
        if (ph == NPHASE - 1) { phase_final_norm(A_out(), A_in(32), wvs__); continue; }
        const int l = (ph - 1) / 9, sub = (ph - 1) % 9;
        const float* modl = (const float*)(A_ws() + WS_MOD) + (size_t)l * NSEQ * 6144;
        const float* xp = l == 0 ? A_in(0) : A_out() + O_YP;
        const float* xs = l == 0 ? A_in(1) : A_out() + O_YS;
        bf16_t* HB = (bf16_t*)(A_ws() + WS_HB);
        if (sub == 0) {
            phase_norm(xp, xs, A_in(10) + l * DM, modl, 0, 1, HB, wvs__);
        } else if (sub == 1) {
            pg8::Gemm g{HB, (const bf16_t*)(A_ws() + WS_WIN) + (size_t)l * NIN * DM, MROWS, NIN, DM};
            pg8::StaticOrder S; S.init(MROWS, NIN, gridDim.x, obid());
            pg8::EpiIn E{l};
            pg8::gemm_phase<pg8::EpiIn, pg8::StaticOrder, true, true>((LAS unsigned char*)lds, g, S, E, wvs__);
        } else if (sub == 2) {
            phase_prep(A, l, lds, wvs__);
        } else if (sub == 3) {
            phase_mix(A, l, lds, wvs__);
        } else if (sub == 4) {
            phase_post(A, l, wvs__);
        } else if (sub == 5 || sub == 8) {
            const bool ffo = (sub == 8);
            pg8::Gemm g{ffo ? (const bf16_t*)(A_ws() + WS_MID) : HB,
                        ffo ? (const bf16_t*)(A_ws() + WS_WFO) + (size_t)l * DM * DFF : (const bf16_t*)(A_ws() + WS_WOUT) + (size_t)l * DM * DM, MP, DM, ffo ? DFF : DM};
            pg8::StaticOrder S; S.init(MP, DM, gridDim.x, obid());
            pg8::EpiRes E{ffo ? A_out() + O_YP : xp, ffo ? A_out() + O_YS : xs, A_out(), modl + (ffo ? 5 : 2) * DM};
            pg8::gemm_phase<pg8::EpiRes, pg8::StaticOrder, true, true>((LAS unsigned char*)lds, g, S, E, wvs__);
            small_res(lds, g.A + (size_t)MP * g.K, g.K, g.Bt, ffo ? A_out() + O_YS : xs, A_out() + O_YS, modl + (ffo ? 5 : 2) * DM, wvs__);
        } else if (sub == 6) {
            phase_norm(A_out() + O_YP, A_out() + O_YS, A_in(29) + l * DM, modl, 3, 4, HB, wvs__);
        } else {
            pg8::Gemm g{HB, (const bf16_t*)(A_ws() + WS_WFI) + (size_t)l * NFI * DM, MP, NFI, DM};
            pg8::StaticOrder S; S.init(MP, NFI, gridDim.x, obid());
            pg8::EpiSwiglu E{(bf16_t*)(A_ws() + WS_MID)};
            pg8::gemm_phase<pg8::EpiSwiglu, pg8::StaticOrder, true, true>((LAS unsigned char*)lds, g, S, E, wvs__);
            small_swiglu(lds, HB + (size_t)MP * DM, g.Bt, (bf16_t*)(A_ws() + WS_MID) + (size_t)MP * DFF, wvs__);
        }
    }
}

extern "C" void kernel_launch(void* const* d_in, const int* in_sizes, int n_in, void* d_out, int out_size, void* d_ws, size_t ws_size, hipStream_t stream) {
    static int grid = 0;
    if (grid == 0) {
        if (n_in != 33 || (size_t)out_size != O_END || ws_size < WS_END2) {
            fprintf(stderr, "kernel_launch: unexpected shapes: n_in %d out %d ws %zu (need %zu)\n", n_in, out_size, ws_size, (size_t)WS_END); grid = -1; return; }
        int dev = 0, cus = 0, per_cu = 0;
        (void)hipGetDevice(&dev);
        (void)hipDeviceGetAttribute(&cus, hipDeviceAttributeMultiprocessorCount, dev);
        if (hipFuncSetAttribute((const void*)fwd_kernel, hipFuncAttributeMaxDynamicSharedMemorySize, LDS_BYTES) != hipSuccess) { fprintf(stderr, "kernel_launch: hipFuncSetAttribute failed\n"); grid = -1; return; }
        if (hipOccupancyMaxActiveBlocksPerMultiprocessor(&per_cu, (const void*)fwd_kernel, NTHR, LDS_BYTES) != hipSuccess || per_cu < 1) per_cu = 1;
        (void)hipGetLastError();
        grid = cus * per_cu;
        if (grid < 1) grid = 256;
    }
    if (grid < 0) return;
    Args a{};
    for (int i = 0; i < 33; ++i) a.in[i] = (const float*)d_in[i];
    a.out = (float*)d_out; a.ws = (unsigned char*)d_ws;
#if ONE_LAUNCH
    a.ph_lo = 0; a.ph_hi = NPHASE;
    void* args[] = {&a};
    hipError_t e = hipLaunchCooperativeKernel((const void*)fwd_kernel, dim3(grid), dim3(NTHR), args, LDS_BYTES, stream);
    if (e != hipSuccess) fprintf(stderr, "cooperative launch failed: %s (grid %d)\n", hipGetErrorString(e), grid);
#else
    for (int ph = 0; ph < NPHASE; ++ph) {
        a.ph_lo = ph; a.ph_hi = ph + 1;
        hipLaunchKernelGGL(fwd_kernel, dim3(grid), dim3(NTHR), LDS_BYTES, stream, a);
    }
#endif
}
```
